# Optimizing an MI355X kernel written in HIP

```python
import math
import jax, jax.numpy as jnp
from jax import lax
import numpy as np

D_MODEL = 1024
BATCH = 2
SEQ = 8192
DEPTH = 2

GRID_W = 64
CTX_LEN = 256
HEAD_DIM = 64
ROPE_THETA = 10000.0
EPS = 1e-6
Q_BLOCK = 128
NEG = -1e30

A_HEADS = 4
A_DQK = 64
A_DV = 2 * A_DQK
B_HEADS = 8
B_KV_HEADS = 2
B_DH = 64
WINDOW = 128
C_HEADS = 8
C_Q_RANK = 256
C_KV_RANK = 128
C_NOPE = 64
C_ROPE = 32
C_DV = 64
D_HEADS = 4
D_DK = 64
D_DV = 128
D_GATE_RANK = 16
D_GATE_TAU = 16.0
D_CHUNK = 64
P_HEADS = 8
P_NKEYS = 128
P_EXPERTS = P_NKEYS * P_NKEYS
P_DKEY = 256
P_TOPK = 16
P_TOK_BLOCK = 128

EVEN_SIZES = (A_HEADS * 2 * A_DQK, A_HEADS * 2 * A_DQK, A_HEADS * A_DV,
              B_HEADS * B_DH, B_KV_HEADS * B_DH, B_KV_HEADS * B_DH)
ODD_SIZES = (C_Q_RANK, C_KV_RANK, C_ROPE,
             D_HEADS * D_DK, D_HEADS * D_DK, D_HEADS * D_DV, D_GATE_RANK, D_GATE_RANK, D_HEADS * D_DV)
EVEN_IN = sum(EVEN_SIZES)
ODD_IN = sum(ODD_SIZES)

kernel_name = "hybrid_diffusion_diffattn_swa_mla_gla_peer"

F32 = jnp.float32


def rmsnorm(x, g):
    xf = x.astype(F32)
    y = xf * lax.rsqrt(jnp.mean(xf * xf, axis=-1, keepdims=True) + EPS)
    return (y * g.astype(F32)).astype(x.dtype)


def modulate(h, shift, scale):
    return h * (1 + scale) + shift


def modulation(cvec, w_mod, b_mod):
    m = jax.nn.silu(cvec) @ w_mod + b_mod
    return jnp.split(m, 6, axis=-1)


def split_cols(z, sizes):
    out, o = [], 0
    for s in sizes:
        out.append(z[..., o:o + s])
        o += s
    return out


def axial_rope_tables(n_tok, rot_dim):
    rows = n_tok // GRID_W
    r, cc = jnp.meshgrid(jnp.arange(rows, dtype=F32), jnp.arange(GRID_W, dtype=F32), indexing="ij")
    axis_dim = rot_dim // 2
    inv = 1.0 / (ROPE_THETA ** (jnp.arange(0, axis_dim, 2, dtype=F32) / axis_dim))
    ang = jnp.concatenate([r.reshape(-1, 1) * inv, cc.reshape(-1, 1) * inv], axis=-1)
    return jnp.cos(ang), jnp.sin(ang)


def apply_rope(t, cos, sin):
    shp = (1, cos.shape[0]) + (1,) * (t.ndim - 3) + (cos.shape[-1],)
    cs, sn = cos.reshape(shp), sin.reshape(shp)
    t1, t2 = t[..., 0::2].astype(F32), t[..., 1::2].astype(F32)
    out = jnp.stack([t1 * cs - t2 * sn, t1 * sn + t2 * cs], axis=-1).reshape(t.shape)
    return out.astype(t.dtype)


def sweep_query_blocks(fn, q, *ops):
    B, T = q.shape[:2]
    nb = T // Q_BLOCK
    qb = jnp.moveaxis(q.reshape((B, nb, Q_BLOCK) + q.shape[2:]), 1, 0)
    out = lax.map(lambda qq: fn(qq, *ops), qb)
    out = jnp.moveaxis(out, 0, 1)
    return out.reshape((B, T) + out.shape[3:])


def diff_attn(q, k, v, lam):
    s = jnp.einsum("bqhmd,bkhmd->bhmqk", q, k).astype(F32) * (A_DQK ** -0.5)
    p = jax.nn.softmax(s, axis=-1)
    w = p[:, :, 0] - lam * p[:, :, 1]
    return jnp.einsum("bhqk,bkhv->bqhv", w.astype(v.dtype), v)


def softmax_attn(q, k, v, scale):
    s = jnp.einsum("bqhd,bkhd->bhqk", q, k).astype(F32) * scale
    p = jax.nn.softmax(s, axis=-1)
    return jnp.einsum("bhqk,bkhv->bqhv", p.astype(v.dtype), v)


def window_gqa_latent(q, k, v, kc, vc, sink):
    B, S, Hq, d = q.shape
    Hkv = k.shape[2]
    G = Hq // Hkv
    nb = S // Q_BLOCK
    L = kc.shape[1]
    scale = d ** -0.5

    def band(t):
        tp = jnp.pad(t, ((0, 0), (Q_BLOCK, Q_BLOCK), (0, 0), (0, 0))).reshape(B, nb + 2, Q_BLOCK, Hkv, d)
        return jnp.concatenate([tp[:, :-2], tp[:, 1:-1], tp[:, 2:]], axis=2)

    kb = jnp.moveaxis(band(k), 1, 0)
    vb = jnp.moveaxis(band(v), 1, 0)
    qb = jnp.moveaxis(q.reshape(B, nb, Q_BLOCK, Hkv, G, d), 1, 0)
    starts = jnp.arange(nb) * Q_BLOCK
    rel = jnp.arange(3 * Q_BLOCK)[None, :] - Q_BLOCK - jnp.arange(Q_BLOCK)[:, None]
    sink_l = sink.reshape(Hkv, G).astype(F32)

    def one(args):
        qq, kk, vv, st = args
        kpos = st - Q_BLOCK + jnp.arange(3 * Q_BLOCK)
        valid = (jnp.abs(rel) <= WINDOW) & ((kpos >= 0) & (kpos < S))[None, :]
        s_loc = jnp.einsum("bqhgd,bkhd->bhgqk", qq, kk).astype(F32) * scale
        s_loc = jnp.where(valid, s_loc, NEG)
        s_ctx = jnp.einsum("bqhgd,blhd->bhgql", qq, kc).astype(F32) * scale
        s_snk = jnp.broadcast_to(sink_l[None, :, :, None, None], s_ctx.shape[:-1] + (1,))
        p = jax.nn.softmax(jnp.concatenate([s_ctx, s_loc, s_snk], axis=-1), axis=-1)
        o = (jnp.einsum("bhgql,blhd->bqhgd", p[..., :L].astype(vc.dtype), vc)
             + jnp.einsum("bhgqk,bkhd->bqhgd", p[..., L:L + 3 * Q_BLOCK].astype(vv.dtype), vv))
        return o.reshape(B, Q_BLOCK, Hq, d)

    out = lax.map(one, (qb, kb, vb, starts))
    return jnp.moveaxis(out, 0, 1).reshape(B, S, Hq, d)


def ctx_gqa_sink(q, k, v, sink):
    B, L, Hq, d = q.shape
    Hkv = k.shape[2]
    G = Hq // Hkv
    qg = q.reshape(B, L, Hkv, G, d)
    s = jnp.einsum("bqhgd,bkhd->bhgqk", qg, k).astype(F32) * (d ** -0.5)
    snk = jnp.broadcast_to(sink.reshape(Hkv, G).astype(F32)[None, :, :, None, None], s.shape[:-1] + (1,))
    p = jax.nn.softmax(jnp.concatenate([s, snk], axis=-1), axis=-1)[..., :-1]
    return jnp.einsum("bhgqk,bkhd->bqhgd", p.astype(v.dtype), v).reshape(B, L, Hq, d)


def gla_chunked(q, k, v, g, s0):
    B, T, H, dk = q.shape
    dv = v.shape[-1]
    C = D_CHUNK
    n = T // C
    rs = lambda t: t.astype(F32).reshape(B, n, C, H, t.shape[-1])
    qf, kf, vf, gf = rs(q), rs(k), rs(v), rs(g)
    b = jnp.cumsum(gf, axis=2)
    b_last = b[:, :, -1:]
    q_t = qf * jnp.exp(b)
    k_in = kf * jnp.exp(-b)
    k_st = kf * jnp.exp(b_last - b)
    mask = jnp.tril(jnp.ones((C, C), dtype=bool))
    a = jnp.where(mask, jnp.einsum("bnchk,bnshk->bnhcs", q_t, k_in), 0.0)
    o_intra = jnp.einsum("bnhcs,bnshv->bnchv", a, vf)
    ds = jnp.einsum("bnchk,bnchv->nbhkv", k_st, vf)
    decay = jnp.moveaxis(jnp.exp(b_last[:, :, 0]), 1, 0)

    def step(s, inp):
        dcy, dsn = inp
        return dcy[..., None] * s + dsn, s

    s_fin, s_start = lax.scan(step, s0.astype(F32), (decay, ds))
    o_inter = jnp.einsum("bnchk,nbhkv->bnchv", q_t, s_start)
    o = (o_intra + o_inter).reshape(B, T, H, dv)
    return o.astype(v.dtype), s_fin


def mix_even(hx, hc, w_in, w_out, a_qn, a_kn, a_lq1, a_lk1, a_lq2, a_lk2, a_gn, b_qn, b_kn, b_sink,
             lam_init, rope, need_ctx):
    cos, sin = rope

    def proj(h):
        B, T = h.shape[:2]
        aq, ak, av, bq, bk, bv = split_cols(h @ w_in, EVEN_SIZES)
        aq = rmsnorm(aq.reshape(B, T, A_HEADS, 2, A_DQK), a_qn)
        ak = rmsnorm(ak.reshape(B, T, A_HEADS, 2, A_DQK), a_kn)
        av = av.reshape(B, T, A_HEADS, A_DV)
        bq = rmsnorm(bq.reshape(B, T, B_HEADS, B_DH), b_qn)
        bk = rmsnorm(bk.reshape(B, T, B_KV_HEADS, B_DH), b_kn)
        bv = bv.reshape(B, T, B_KV_HEADS, B_DH)
        return aq, ak, av, bq, bk, bv

    xaq, xak, xav, xbq, xbk, xbv = proj(hx)
    caq, cak, cav, cbq, cbk, cbv = proj(hc)
    xaq, xak = apply_rope(xaq, cos, sin), apply_rope(xak, cos, sin)
    xbq, xbk = apply_rope(xbq, cos, sin), apply_rope(xbk, cos, sin)
    lam = (jnp.exp(jnp.sum(a_lq1.astype(F32) * a_lk1.astype(F32)))
           - jnp.exp(jnp.sum(a_lq2.astype(F32) * a_lk2.astype(F32))) + lam_init)

    ka = jnp.concatenate([cak, xak], axis=1)
    va = jnp.concatenate([cav, xav], axis=1)
    ox_a = sweep_query_blocks(diff_attn, xaq, ka, va, lam)
    ox_b = window_gqa_latent(xbq, xbk, xbv, cbk, cbv, b_sink)

    def merge(oa, ob):
        B, T = oa.shape[:2]
        oa = rmsnorm(oa, a_gn) * (1.0 - lam_init)
        return jnp.concatenate([oa.reshape(B, T, -1), ob.reshape(B, T, -1).astype(oa.dtype)], axis=-1) @ w_out

    out_x = merge(ox_a, ox_b)
    out_c = merge(diff_attn(caq, cak, cav, lam), ctx_gqa_sink(cbq, cbk, cbv, b_sink)) if need_ctx else None
    return out_x, out_c


def mix_odd(hx, hc, w_in, w_out, c_gq, c_gkv, c_wq_up, c_wkv_up, c_qn, c_kn,
            d_wg_f, d_bg_f, d_wg_b, d_bg_b, d_gn, rope, need_ctx):
    cos, sin = rope

    def proj(h):
        B, T = h.shape[:2]
        cq, ckv, kpe, dq, dk, dv, gf, gb, r = split_cols(h @ w_in, ODD_SIZES)
        q = (rmsnorm(cq, c_gq) @ c_wq_up).reshape(B, T, C_HEADS, C_NOPE + C_ROPE)
        kv = (rmsnorm(ckv, c_gkv) @ c_wkv_up).reshape(B, T, C_HEADS, C_NOPE + C_DV)
        k = jnp.concatenate([kv[..., :C_NOPE],
                             jnp.broadcast_to(kpe[:, :, None, :], (B, T, C_HEADS, C_ROPE))], axis=-1)
        q, k = rmsnorm(q, c_qn), rmsnorm(k, c_kn)
        v = kv[..., C_NOPE:]
        dq = dq.reshape(B, T, D_HEADS, D_DK) * (D_DK ** -0.5)
        dk = dk.reshape(B, T, D_HEADS, D_DK)
        dv = dv.reshape(B, T, D_HEADS, D_DV)
        lg_f = (jax.nn.log_sigmoid((gf @ d_wg_f + d_bg_f).astype(F32)) / D_GATE_TAU).reshape(B, T, D_HEADS, D_DK)
        lg_b = (jax.nn.log_sigmoid((gb @ d_wg_b + d_bg_b).astype(F32)) / D_GATE_TAU).reshape(B, T, D_HEADS, D_DK)
        r = r.reshape(B, T, D_HEADS, D_DV)
        return q, k, v, dq, dk, dv, lg_f, lg_b, r

    xq, xk, xv, xdq, xdk, xdv, xlf, xlb, xr = proj(hx)
    cq, ck, cv, cdq, cdk, cdv, clf, clb, cr = proj(hc)

    def rope_tail(t):
        return jnp.concatenate([t[..., :C_NOPE], apply_rope(t[..., C_NOPE:], cos, sin)], axis=-1)

    xq, xk = rope_tail(xq), rope_tail(xk)
    scale = (C_NOPE + C_ROPE) ** -0.5
    kc_all = jnp.concatenate([ck, xk], axis=1)
    vc_all = jnp.concatenate([cv, xv], axis=1)
    ox_c = sweep_query_blocks(softmax_attn, xq, kc_all, vc_all, scale)

    B = hx.shape[0]
    zeros = jnp.zeros((B, D_HEADS, D_DK, D_DV), F32)
    flip = lambda t: jnp.flip(t, axis=1)
    oc_f, sc_f = gla_chunked(cdq, cdk, cdv, clf, zeros)
    ox_f, _ = gla_chunked(xdq, xdk, xdv, xlf, sc_f)
    oc_br, sc_b = gla_chunked(flip(cdq), flip(cdk), flip(cdv), flip(clb), zeros)
    ox_br, _ = gla_chunked(flip(xdq), flip(xdk), flip(xdv), flip(xlb), sc_b)

    def merge(oc_mla, o_gla, r):
        Bn, T = oc_mla.shape[:2]
        g = (rmsnorm(o_gla, d_gn) * jax.nn.silu(r)).astype(oc_mla.dtype)
        return jnp.concatenate([oc_mla.reshape(Bn, T, -1), g.reshape(Bn, T, -1)], axis=-1) @ w_out

    out_x = merge(ox_c, ox_f + flip(ox_br), xr)
    out_c = merge(softmax_attn(cq, ck, cv, scale), oc_f + flip(oc_br), cr) if need_ctx else None
    return out_x, out_c


def peer(h, wq, sub_keys, u_tab, v_tab):
    T, D = h.shape
    q = (h @ wq).reshape(T, P_HEADS, 2, P_DKEY // 2)
    s = jnp.einsum("thpd,hpnd->thpn", q, sub_keys).astype(F32)
    sv, si = lax.top_k(s, P_TOPK)
    cand = (sv[:, :, 0, :, None] + sv[:, :, 1, None, :]).reshape(T, P_HEADS, P_TOPK * P_TOPK)
    cidx = (si[:, :, 0, :, None] * P_NKEYS + si[:, :, 1, None, :]).reshape(T, P_HEADS, P_TOPK * P_TOPK)
    fv, fi = lax.top_k(cand, P_TOPK)
    eidx = jnp.take_along_axis(cidx, fi, axis=-1).reshape(T, P_HEADS * P_TOPK)
    gate = jax.nn.softmax(fv, axis=-1).reshape(T, P_HEADS * P_TOPK)
    nb = T // P_TOK_BLOCK

    def blk(args):
        hb, ib, gb = args
        a = jax.nn.gelu(jnp.einsum("tkd,td->tk", u_tab[ib], hb).astype(F32), approximate=False) * gb
        return jnp.einsum("tk,tkd->td", a.astype(hb.dtype), v_tab[ib])

    out = lax.map(blk, (h.reshape(nb, P_TOK_BLOCK, D), eidx.reshape(nb, P_TOK_BLOCK, -1),
                        gate.reshape(nb, P_TOK_BLOCK, -1)))
    return out.reshape(T, D)


def setup_inputs(seed: int = 0) -> dict:
    key = jax.random.key(seed)
    ks = iter(jax.random.split(key, 64))
    nrm = lambda shape, scale: jax.random.normal(next(ks), shape, F32) * scale
    gain = lambda shape: 1.0 + nrm(shape, 0.02)
    D = D_MODEL
    NE = (DEPTH + 1) // 2
    NO = DEPTH // 2
    return {
        "x": nrm((BATCH, SEQ, D), 1.0),
        "c": nrm((BATCH, D), 1.0),
        "ctx": nrm((BATCH, CTX_LEN, D), 1.0),
        "c_ctx": nrm((D,), 1.0),
        "w_mod": nrm((DEPTH, D, 6 * D), 0.5 * D ** -0.5),
        "b_mod": nrm((DEPTH, 6 * D), 0.02),
        "norm1": gain((DEPTH, D)),
        "norm2": gain((DEPTH, D)),
        "e_w_in": nrm((NE, D, EVEN_IN), D ** -0.5),
        "e_w_out": nrm((NE, D, D), D ** -0.5),
        "a_qn": gain((NE, A_DQK)),
        "a_kn": gain((NE, A_DQK)),
        "a_lq1": nrm((NE, A_DQK), 0.1),
        "a_lk1": nrm((NE, A_DQK), 0.1),
        "a_lq2": nrm((NE, A_DQK), 0.1),
        "a_lk2": nrm((NE, A_DQK), 0.1),
        "a_gn": gain((NE, A_DV)),
        "b_qn": gain((NE, B_DH)),
        "b_kn": gain((NE, B_DH)),
        "b_sink": nrm((NE, B_HEADS), 0.5),
        "o_w_in": nrm((NO, D, ODD_IN), D ** -0.5),
        "o_w_out": nrm((NO, D, D), D ** -0.5),
        "c_gq": gain((NO, C_Q_RANK)),
        "c_gkv": gain((NO, C_KV_RANK)),
        "c_wq_up": nrm((NO, C_Q_RANK, C_HEADS * (C_NOPE + C_ROPE)), C_Q_RANK ** -0.5),
        "c_wkv_up": nrm((NO, C_KV_RANK, C_HEADS * (C_NOPE + C_DV)), C_KV_RANK ** -0.5),
        "c_qn": gain((NO, C_NOPE + C_ROPE)),
        "c_kn": gain((NO, C_NOPE + C_ROPE)),
        "d_wg_f": nrm((NO, D_GATE_RANK, D_HEADS * D_DK), D_GATE_RANK ** -0.5),
        "d_bg_f": nrm((NO, D_HEADS * D_DK), 0.1),
        "d_wg_b": nrm((NO, D_GATE_RANK, D_HEADS * D_DK), D_GATE_RANK ** -0.5),
        "d_bg_b": nrm((NO, D_HEADS * D_DK), 0.1),
        "d_gn": gain((NO, D_DV)),
        "p_wq": nrm((DEPTH, D, P_HEADS * P_DKEY), D ** -0.5),
        "p_keys": nrm((DEPTH, P_HEADS, 2, P_NKEYS, P_DKEY // 2), (P_DKEY // 2) ** -0.5),
        "p_u": nrm((DEPTH, P_EXPERTS, D), D ** -0.5),
        "p_v": nrm((DEPTH, P_EXPERTS, D), 1.0),
    }


def reference(x, c, ctx, c_ctx, w_mod, b_mod, norm1, norm2, e_w_in, e_w_out, a_qn, a_kn, a_lq1, a_lk1,
              a_lq2, a_lk2, a_gn, b_qn, b_kn, b_sink, o_w_in, o_w_out, c_gq, c_gkv, c_wq_up, c_wkv_up,
              c_qn, c_kn, d_wg_f, d_bg_f, d_wg_b, d_bg_b, d_gn, p_wq, p_keys, p_u, p_v):
    B, S, D = x.shape
    L = ctx.shape[1]
    rope_ab = axial_rope_tables(S, HEAD_DIM)
    rope_c = axial_rope_tables(S, C_ROPE)
    h = ctx
    for i in range(DEPTH):
        last = i == DEPTH - 1
        j = i // 2
        mx = [m[:, None, :] for m in modulation(c, w_mod[i], b_mod[i])]
        mc = modulation(c_ctx, w_mod[i], b_mod[i])
        hx = modulate(rmsnorm(x, norm1[i]), mx[0], mx[1])
        hc = modulate(rmsnorm(h, norm1[i]), mc[0], mc[1])
        if i % 2 == 0:
            lam_init = 0.8 - 0.6 * math.exp(-0.3 * i)
            ox, oc = mix_even(hx, hc, e_w_in[j], e_w_out[j], a_qn[j], a_kn[j], a_lq1[j], a_lk1[j],
                              a_lq2[j], a_lk2[j], a_gn[j], b_qn[j], b_kn[j], b_sink[j],
                              lam_init, rope_ab, not last)
        else:
            ox, oc = mix_odd(hx, hc, o_w_in[j], o_w_out[j], c_gq[j], c_gkv[j], c_wq_up[j], c_wkv_up[j],
                             c_qn[j], c_kn[j], d_wg_f[j], d_bg_f[j], d_wg_b[j], d_bg_b[j], d_gn[j],
                             rope_c, not last)
        x = x + mx[2] * ox
        hx = modulate(rmsnorm(x, norm2[i]), mx[3], mx[4])
        x = x + mx[5] * peer(hx.reshape(B * S, D), p_wq[i], p_keys[i], p_u[i], p_v[i]).reshape(B, S, D)
        if not last:
            h = h + mc[2] * oc
            hc = modulate(rmsnorm(h, norm2[i]), mc[3], mc[4])
            h = h + mc[5] * peer(hc.reshape(B * L, D), p_wq[i], p_keys[i], p_u[i], p_v[i]).reshape(B, L, D)
    return x
```

```cpp
#include <hip/hip_runtime.h>
#include <hip/hip_cooperative_groups.h>
#include <cstdio>
#include <cstdint>
#include <cmath>
namespace cg = cooperative_groups;

#ifndef N_PHASES_RUN
#define N_PHASES_RUN 18
#endif
#ifndef MULTI_LAUNCH
#define MULTI_LAUNCH 0
#endif

typedef unsigned short bf16_t;
typedef unsigned char uchar;
typedef short bf16x8 __attribute__((ext_vector_type(8)));
typedef float f32x16 __attribute__((ext_vector_type(16)));
typedef float f32x4 __attribute__((ext_vector_type(4)));
typedef float f32x2 __attribute__((ext_vector_type(2)));
typedef unsigned u32x4 __attribute__((ext_vector_type(4)));
typedef unsigned u32x2 __attribute__((ext_vector_type(2)));
typedef __bf16 bf16x2v __attribute__((ext_vector_type(2)));
#define LAS __attribute__((address_space(3)))
#define DI __device__ __forceinline__

constexpr int DM = 1024, NB = 2, SEQ = 8192, LCTX = 256, TPB = SEQ + LCTX  , NT = NB * TPB  ;
constexpr float EPS = 1e-6f;
constexpr float LOG2E = 1.4426950408889634f;
constexpr int KSPLIT = 32;
constexpr int NCHUNK = TPB / 64;

constexpr size_t al256(size_t x) { return (x + 255) & ~(size_t)255; }
constexpr size_t OFF_WINE = 0;
constexpr size_t OFF_WOUTE = OFF_WINE + (size_t)2304 * 1024 * 2;
constexpr size_t OFF_WINO = OFF_WOUTE + (size_t)1024 * 1024 * 2;
constexpr size_t OFF_WOUTO = OFF_WINO + (size_t)2048 * 1024 * 2;
constexpr size_t OFF_WQUP = OFF_WOUTO + (size_t)1024 * 1024 * 2;
constexpr size_t OFF_WKVUP = OFF_WQUP + (size_t)768 * 256 * 2;
constexpr size_t OFF_PWQ = OFF_WKVUP + (size_t)1024 * 128 * 2;
constexpr size_t OFF_PKEYS = OFF_PWQ + (size_t)2 * 2048 * 1024 * 2;
constexpr size_t OFF_PU = OFF_PKEYS + (size_t)2 * 16 * 128 * 128 * 2;
constexpr size_t OFF_PV = OFF_PU + (size_t)2 * 16384 * 1024 * 2;
constexpr size_t OFF_MODPART = OFF_PV + (size_t)2 * 16384 * 1024 * 2;
constexpr size_t OFF_MOD = OFF_MODPART + (size_t)KSPLIT * 36864 * 4;
constexpr size_t OFF_ROPEAB = OFF_MOD + (size_t)36864 * 4;
constexpr size_t OFF_ROPEC = OFF_ROPEAB + (size_t)8192 * 64 * 4;
constexpr size_t OFF_SCAL = OFF_ROPEC + (size_t)8192 * 32 * 4;
constexpr size_t OFF_BAR = OFF_SCAL + 256;
constexpr size_t OFF_HRES = OFF_BAR + 16384;
constexpr size_t OFF_HBF = OFF_HRES + (size_t)512 * 1024 * 4;
constexpr size_t OFF_AOUT = OFF_HBF + (size_t)NT * 1024 * 2;
constexpr size_t OFF_SSQ64 = OFF_AOUT + (size_t)NT * 1024 * 2;
constexpr size_t OFF_ATT = OFF_SSQ64 + (size_t)NT * 8 * 4;
constexpr size_t SZ_QK64 = (size_t)TPB * 64 * 2;
constexpr size_t OFF_AQ = OFF_ATT;
constexpr size_t OFF_AK = OFF_AQ + 16 * SZ_QK64;
constexpr size_t OFF_AVT = OFF_AK + 16 * SZ_QK64;
constexpr size_t OFF_BQ = OFF_AVT + (size_t)8 * 128 * TPB * 2;
constexpr size_t OFF_BK = OFF_BQ + 16 * SZ_QK64;
constexpr size_t OFF_BVT = OFF_BK + 4 * SZ_QK64;
constexpr size_t OFF_ATT_END0 = OFF_BVT + (size_t)4 * 64 * TPB * 2;
constexpr size_t SZ_QK32 = (size_t)TPB * 32 * 2;
constexpr size_t OFF_CQN = OFF_ATT;
constexpr size_t OFF_CQR = OFF_CQN + 16 * SZ_QK64;
constexpr size_t OFF_CKN = OFF_CQR + 16 * SZ_QK32;
constexpr size_t OFF_CKR = OFF_CKN + 16 * SZ_QK64;
constexpr size_t OFF_CVT = OFF_CKR + 16 * SZ_QK32;
constexpr size_t OFF_ATT_END1 = OFF_CVT + (size_t)16 * 64 * TPB * 2;
constexpr size_t OFF_R1 = (OFF_ATT_END0 > OFF_ATT_END1 ? OFF_ATT_END0 : OFF_ATT_END1);
constexpr size_t OFF_SCORES = OFF_R1;
constexpr size_t OFF_PQ = OFF_R1 + (size_t)NT * 2048 * 2;
constexpr size_t OFF_H8 = OFF_PQ;
constexpr size_t OFF_PROJ1 = OFF_R1;
constexpr size_t OFF_GDS = OFF_PROJ1 + (size_t)NT * 2048 * 2;
constexpr size_t OFF_GDEC = OFF_GDS + (size_t)2112 * 8192 * 4;
constexpr size_t OFF_R1_END_A = OFF_SCORES + (size_t)NT * 2048 * 4;
constexpr size_t OFF_R1_END_B = OFF_GDEC + (size_t)2112 * 64 * 4;
constexpr size_t OFF_EIDX = (OFF_R1_END_A > OFF_R1_END_B ? OFF_R1_END_A : OFF_R1_END_B);
constexpr size_t OFF_GATE = OFF_EIDX + (size_t)NT * 128 * 2;
constexpr size_t WS_NEEDED = OFF_GATE + (size_t)NT * 128 * 4;

constexpr int NTHR = 512, NW = 8;
constexpr int LDS_BYTES = 147456 + 16;

struct Params {
    const float *x, *c, *ctx, *c_ctx, *w_mod, *b_mod, *norm1, *norm2, *e_w_in, *e_w_out, *a_qn, *a_kn, *a_lq1, *a_lk1, *a_lq2, *a_lk2,
        *a_gn, *b_qn, *b_kn, *b_sink, *o_w_in, *o_w_out, *c_gq, *c_gkv, *c_wq_up, *c_wkv_up, *c_qn, *c_kn, *d_wg_f, *d_bg_f, *d_wg_b,
        *d_bg_b, *d_gn, *p_wq, *p_keys, *p_u, *p_v;
    float* out;
    uchar* ws;
    int phase_lo, phase_hi;
};

DI unsigned pk2(float a, float b) { return __builtin_bit_cast(unsigned, __builtin_convertvector((f32x2){a, b}, bf16x2v)); }
typedef int i32x8 __attribute__((ext_vector_type(8)));
DI float bflo(unsigned u) { return __uint_as_float(u << 16); }
DI float bfhi(unsigned u) { return __uint_as_float(u & 0xffff0000u); }
DI float bf2f(bf16_t v) { return __uint_as_float(((unsigned)v) << 16); }
DI bf16_t f2bf(float f) { return (bf16_t)(pk2(f, 0.f) & 0xffffu); }
DI int crow(int reg, int h) { return (reg & 3) + 8 * (reg >> 2) + 4 * h; }
DI int perm16(int t) { return (t & ~12) | ((t & 4) << 1) | ((t & 8) >> 1); }
DI float wave_sum(float v) {
#pragma unroll
    for (int o = 32; o >= 1; o >>= 1) v += __shfl_xor(v, o);
    return v;
}
DI float wave_max(float v) {
#pragma unroll
    for (int o = 32; o >= 1; o >>= 1) v = fmaxf(v, __shfl_xor(v, o));
    return v;
}
DI float silu_f(float x) { return x / (1.f + __expf(-x)); }
#define MFMA32(a, b, c) __builtin_amdgcn_mfma_f32_32x32x16_bf16((a), (b), (c), 0, 0, 0)

DI const float* in_row(const Params& p, int tok) {
    const int b = tok / TPB, i = tok - b * TPB;
    return i < LCTX ? p.ctx + ((size_t)b * LCTX + i) * DM : p.x + ((size_t)b * SEQ + (i - LCTX)) * DM;
}
DI float* res_row(const Params& p, int tok) {
    const int b = tok / TPB, i = tok - b * TPB;
    return i < LCTX ? (float*)(p.ws + OFF_HRES) + ((size_t)b * LCTX + i) * DM : p.out + ((size_t)b * SEQ + (i - LCTX)) * DM;
}
DI int mod_id(int tok) { const int b = tok / TPB, i = tok - b * TPB; return i < LCTX ? 2 : b; }

DI unsigned t128_off(int row, int chunk) { return (unsigned)(row * 128 + ((chunk ^ ((row >> 1) & 7)) << 4)); }
DI unsigned t64_off(int row, int chunk) { return (unsigned)(row * 64 + ((chunk ^ ((row >> 2) & 3)) << 4)); }
DI bf16x8 ldsfrag(const LAS uchar* base, unsigned off) { return *(const LAS bf16x8*)(base + off); }

DI void dma_t128(LAS uchar* lds, const uchar* g, size_t gstride, int nrows, int wave, int lane) {
    const int rin = lane >> 3, cpos = lane & 7;
    for (int r0 = wave * 8; r0 < nrows; r0 += 8 * NW) {
        const int row = r0 + rin;
        const int sc = cpos ^ ((row >> 1) & 7);
        __builtin_amdgcn_global_load_lds((const unsigned*)(g + (size_t)row * gstride + sc * 16), (LAS unsigned*)(lds + r0 * 128), 16, 0, 0);
    }
}
DI void dma_t64(LAS uchar* lds, const uchar* g, size_t gstride, int wave, int lane) {
    if (lane < 32) {
        const int row = wave * 8 + (lane >> 2), cpos = lane & 3;
        const int sc = cpos ^ ((row >> 2) & 3);
        __builtin_amdgcn_global_load_lds((const unsigned*)(g + (size_t)row * gstride + sc * 16), (LAS unsigned*)(lds + wave * 512), 16, 0, 0);
    }
}
#define WAIT_VM0() asm volatile("s_waitcnt vmcnt(0)" ::: "memory")
template <int N> DI void wait_vmcnt() { asm volatile("s_waitcnt vmcnt(%0)" ::"n"(N) : "memory"); }
#define RAW_BAR() do { asm volatile("" ::: "memory"); __builtin_amdgcn_s_barrier(); asm volatile("" ::: "memory"); } while (0)

DI int grp_row(int f) { const int fl = f & 255; return (f & ~255) + 128 * ((fl >> 5) & 1) + 32 * (fl >> 6) + (fl & 31); }
struct RowId { DI int operator()(int r) const { return r; } };
struct RowGrp { int base; DI int operator()(int r) const { return grp_row(base + r); } };
template <int WM, int WN, int NST, class RowMap = RowId>
DI void gemm_block(LAS uchar* lds, const bf16_t* Wt, int ldw, const bf16_t* X, int ldx, int K, f32x16 (&acc)[WM][WN], RowMap rm = RowMap()) {
    constexpr int FB = 64 * WM, TB = 128 * WN, STG = (FB + TB) * 128, NDMA = FB / 64 + TB / 64;
    static_assert(NST * STG <= 147456, "LDS");
    const int tid = threadIdx.x, wave = __builtin_amdgcn_readfirstlane(tid >> 6), lane = tid & 63, r = lane & 31, h = lane >> 5, wf = wave >> 2, wt = wave & 3;
#pragma unroll
    for (int i = 0; i < WM; ++i)
#pragma unroll
        for (int j = 0; j < WN; ++j)
#pragma unroll
            for (int e = 0; e < 16; ++e) acc[i][j][e] = 0.f;
    const int nk = K / 64;
    const int rin = lane >> 3, cpos = lane & 7;
    auto piece = [&](int kt, int st, int pc) {
        LAS uchar* sp = lds + st * STG;
        const bool isw = pc < FB / 64;
        const int r0 = (isw ? pc : pc - FB / 64) * 64 + wave * 8, row = r0 + rin, sc = cpos ^ ((row >> 1) & 7);
        const uchar* g = isw ? (const uchar*)(Wt + kt * 64) + (size_t)rm(row) * ((size_t)ldw * 2) : (const uchar*)(X + kt * 64) + (size_t)row * ((size_t)ldx * 2);
        __builtin_amdgcn_global_load_lds((const unsigned*)(g + sc * 16), (LAS unsigned*)(sp + (isw ? 0 : FB * 128) + r0 * 128), 16, 0, 0);
    };
#pragma unroll
    for (int s0 = 0; s0 < NST - 1; ++s0)
        if (s0 < nk) {
#pragma unroll
            for (int pc = 0; pc < NDMA; ++pc) piece(s0, s0, pc);
        }
    int cs = 0, is = NST - 1;
    for (int kt = 0; kt < nk; ++kt) {
        if (kt + NST - 2 < nk) wait_vmcnt<(NST - 2) * NDMA>(); else wait_vmcnt<0>();
        RAW_BAR();
        const bool more = kt + NST - 1 < nk;
        const LAS uchar* cur = lds + cs * STG;
#pragma unroll
        for (int kk = 0; kk < 4; ++kk) {
            bf16x8 a[WM], b[WN];
#pragma unroll
            for (int i = 0; i < WM; ++i) a[i] = ldsfrag(cur, t128_off(wf * WM * 32 + i * 32 + r, 2 * kk + h));
#pragma unroll
            for (int j = 0; j < WN; ++j) b[j] = ldsfrag(cur + FB * 128, t128_off(wt * WN * 32 + j * 32 + r, 2 * kk + h));
#pragma unroll
            for (int i = 0; i < WM; ++i)
#pragma unroll
                for (int j = 0; j < WN; ++j) acc[i][j] = MFMA32(a[i], b[j], acc[i][j]);
            if (more) {
#pragma unroll
                for (int pc = kk * NDMA / 4; pc < (kk + 1) * NDMA / 4; ++pc) piece(kt + NST - 1, is, pc);
            }
        }
        cs = cs + 1 == NST ? 0 : cs + 1; is = is + 1 == NST ? 0 : is + 1;
    }
    __syncthreads();
}

namespace pg8 {
#define PG8_LAS __attribute__((address_space(3)))
constexpr int BM = 256, BK = 64, HALF = 128, HTB = HALF * BK * 2  , STAGE_BYTES = 8 * HTB;
DI int lds_byte(int r, int c) { const int st = (r >> 4) * 2 + (c >> 5), rr = r & 15, cc = c & 31, ob = rr * 64 + cc * 2; return st * 1024 + (ob ^ (((ob >> 9) & 1) << 5)); }
DI void stage_rc(int b, int& R, int& C) { const int st = b / 1024, sb = b % 1024, swz = sb ^ (((sb >> 9) & 1) << 5); R = (st >> 1) * 16 + swz / 64; C = (st & 1) * 32 + (swz % 64) / 2; }
DI int perm32(int rho) { const int n = rho >> 4, i = rho & 15; return 8 * (i >> 2) + 4 * n + (i & 3); }
struct Unit { int pm, pn; };
struct Gemm { const bf16_t* A; const bf16_t* Bt; int M, N, K; };
template <class Epi, class Sched, bool ALIGN_EPI = false, bool SP2 = false>
__device__ __forceinline__ void gemm_phase(PG8_LAS unsigned char* lds, const Gemm g, const Sched& S, const Epi& E) {
    const int tid = threadIdx.x, wid = __builtin_amdgcn_readfirstlane(tid >> 6), lane = tid & 63, wr = wid >> 2, wc = wid & 3, fr = lane & 15, fq = lane >> 4;
    const int K = g.K, nt = K / BK;
    unsigned voffA[2], voffB[2];
#pragma unroll
    for (int i = 0; i < 2; ++i) { int R, C; stage_rc(tid * 16 + i * 8192, R, C); const int Rb = Epi::PERM ? ((R & ~31) + perm32(R & 31)) : R;
        voffA[i] = (unsigned)(R * K + C) * 2u; voffB[i] = (unsigned)(Rb * K + C) * 2u; }
    const size_t kstep = (size_t)(BK * 2);
    const size_t hstep = (size_t)HALF * K * 2;
    const size_t tstep = 2 * hstep;
    const unsigned ldsw = (unsigned)wid * 1024u;
    const int aoff = lds_byte(wr * 64 + fr, fq * 8), boff = lds_byte(wc * 32 + fr, fq * 8);
#define PG8_SA(b, h) (((b) * 2 + (h)) * HTB)
#define PG8_SB(b, h) ((4 + (b) * 2 + (h)) * HTB)
#define PG8_STAGE(bufoff, gbase, voff) do { _Pragma("unroll") for (int _i = 0; _i < 2; ++_i) \
        __builtin_amdgcn_global_load_lds((const unsigned*)((const char*)(gbase) + (voff)[_i]), (PG8_LAS unsigned*)(lds + (bufoff) + ldsw + _i * 8192), 16, 0, 0); } while (0)
#define PG8_LDA(dst, b, h) do { _Pragma("unroll") for (int m = 0; m < 4; ++m) _Pragma("unroll") for (int k = 0; k < 2; ++k) dst[m][k] = *(const PG8_LAS bf16x8*)(lds + PG8_SA(b, h) + aoff + m * 2048 + k * 1024); } while (0)
#define PG8_LDB(dst, b, h) do { _Pragma("unroll") for (int n = 0; n < 2; ++n) _Pragma("unroll") for (int k = 0; k < 2; ++k) dst[n][k] = *(const PG8_LAS bf16x8*)(lds + PG8_SB(b, h) + boff + n * 2048 + k * 1024); } while (0)
#define PG8_MMA(ai, bj, At, Bt) do { __builtin_amdgcn_s_setprio(1); _Pragma("unroll") for (int m = 0; m < 4; ++m) _Pragma("unroll") for (int n = 0; n < 2; ++n) _Pragma("unroll") for (int k = 0; k < 2; ++k) \
        acc[ai][bj][m][n] = __builtin_amdgcn_mfma_f32_16x16x32_bf16(Bt[n][k], At[m][k], acc[ai][bj][m][n], 0, 0, 0); __builtin_amdgcn_s_setprio(0); } while (0)
#define PG8_WAIT_V(n) asm volatile("s_waitcnt vmcnt(" #n ")" ::: "memory")
#define PG8_WAIT_L(n) asm volatile("s_waitcnt lgkmcnt(" #n ")" ::: "memory")
#define PG8_BAR __builtin_amdgcn_s_barrier()
#define PG8_SCHED __builtin_amdgcn_sched_barrier(0)
    Unit cur, nxt; int ui = 0;
    if (!S.next(0, cur)) return;
    f32x4 acc[2][2][4][2];
#pragma unroll
    for (int a = 0; a < 2; ++a)
#pragma unroll
        for (int b = 0; b < 2; ++b)
#pragma unroll
            for (int m = 0; m < 4; ++m)
#pragma unroll
                for (int n = 0; n < 2; ++n) acc[a][b][m][n] = (f32x4){0.f, 0.f, 0.f, 0.f};
    bf16x8 At[4][2], B0[2][2], B1[2][2];
    const char* cA = (const char*)g.A + (size_t)cur.pm * tstep; const char* cB = (const char*)g.Bt + (size_t)cur.pn * tstep;
    S.a_ready(cur);
    if constexpr (SP2) {
        PG8_STAGE(PG8_SB(0, 0), cB, voffB); PG8_STAGE(PG8_SB(0, 1), cB + hstep, voffB); PG8_STAGE(PG8_SA(0, 0), cA, voffA); PG8_STAGE(PG8_SA(0, 1), cA + hstep, voffA);
        if (wr == 1) PG8_BAR;
        PG8_WAIT_V(2); PG8_BAR;
        PG8_STAGE(PG8_SB(1, 0), cB + kstep, voffB); PG8_STAGE(PG8_SA(1, 0), cA + kstep, voffA); PG8_STAGE(PG8_SB(1, 1), cB + hstep + kstep, voffB);
        PG8_WAIT_V(6); PG8_BAR;
    } else {
        PG8_STAGE(PG8_SB(0, 0), cB, voffB); PG8_STAGE(PG8_SA(0, 0), cA, voffA); PG8_STAGE(PG8_SB(0, 1), cB + hstep, voffB); PG8_STAGE(PG8_SA(0, 1), cA + hstep, voffA);
        if (wr == 1) PG8_BAR;
        PG8_WAIT_V(4); PG8_BAR;
        PG8_STAGE(PG8_SB(1, 0), cB + kstep, voffB); PG8_STAGE(PG8_SA(1, 0), cA + kstep, voffA); PG8_STAGE(PG8_SB(1, 1), cB + hstep + kstep, voffB);
        PG8_WAIT_V(6); PG8_BAR;
    }
    for (;;) {
        const bool has_next = S.next(ui + 1, nxt);
        const char* nA = has_next ? (const char*)g.A + (size_t)nxt.pm * tstep : cA; const char* nB = has_next ? (const char*)g.Bt + (size_t)nxt.pn * tstep : cB;
        for (int t = 0; t < nt; t += 2) {
            const bool last = (t == nt - 2);
            const char* a1 = cA + (size_t)(t + 1) * kstep;
            const char* a2 = last ? nA : cA + (size_t)(t + 2) * kstep; const char* b2 = last ? nB : cB + (size_t)(t + 2) * kstep;
            const char* a3 = a2 + kstep; const char* b3 = b2 + kstep;
            if (last && has_next) S.a_ready(nxt);
            if constexpr (SP2) {
            PG8_LDB(B0, 0, 0); PG8_LDB(B1, 0, 1); PG8_SCHED; PG8_LDA(At, 0, 0); PG8_STAGE(PG8_SA(1, 1), a1 + hstep, voffA);
            PG8_WAIT_V(8); PG8_WAIT_L(0); PG8_BAR; PG8_MMA(0, 0, At, B0); PG8_MMA(0, 1, At, B1); PG8_BAR; PG8_SCHED;
            PG8_LDA(At, 0, 1); PG8_STAGE(PG8_SB(0, 0), b2, voffB); PG8_STAGE(PG8_SB(0, 1), b2 + hstep, voffB); PG8_STAGE(PG8_SA(0, 0), a2, voffA);
            PG8_WAIT_V(8); PG8_WAIT_L(0); PG8_BAR; PG8_MMA(1, 0, At, B0); PG8_MMA(1, 1, At, B1); PG8_BAR; PG8_SCHED;
            PG8_LDB(B0, 1, 0); PG8_LDB(B1, 1, 1); PG8_SCHED; PG8_LDA(At, 1, 0); PG8_STAGE(PG8_SA(0, 1), a2 + hstep, voffA);
            PG8_WAIT_V(8); PG8_WAIT_L(0); PG8_BAR; PG8_MMA(0, 0, At, B0); PG8_MMA(0, 1, At, B1); PG8_BAR; PG8_SCHED;
            PG8_LDA(At, 1, 1); PG8_STAGE(PG8_SB(1, 0), b3, voffB); PG8_STAGE(PG8_SB(1, 1), b3 + hstep, voffB); PG8_STAGE(PG8_SA(1, 0), a3, voffA);
            PG8_WAIT_V(8); PG8_WAIT_L(0); PG8_BAR; PG8_MMA(1, 0, At, B0); PG8_MMA(1, 1, At, B1); PG8_BAR; PG8_SCHED;
            } else {
            PG8_LDB(B0, 0, 0); PG8_SCHED; PG8_LDA(At, 0, 0); PG8_STAGE(PG8_SA(1, 1), a1 + hstep, voffA);
            PG8_WAIT_L(8); PG8_BAR; PG8_WAIT_L(0); PG8_MMA(0, 0, At, B0); PG8_BAR; PG8_SCHED;
            PG8_LDB(B1, 0, 1); PG8_STAGE(PG8_SB(0, 0), b2, voffB);
            PG8_BAR; PG8_WAIT_L(0); PG8_MMA(0, 1, At, B1); PG8_BAR;
            PG8_LDA(At, 0, 1); PG8_STAGE(PG8_SA(0, 0), a2, voffA);
            PG8_BAR; PG8_WAIT_L(0); PG8_MMA(1, 0, At, B0); PG8_BAR; PG8_SCHED;
            PG8_STAGE(PG8_SB(0, 1), b2 + hstep, voffB);
            PG8_WAIT_V(6); PG8_BAR; PG8_MMA(1, 1, At, B1); PG8_BAR;
            PG8_LDB(B0, 1, 0); PG8_SCHED; PG8_LDA(At, 1, 0); PG8_STAGE(PG8_SA(0, 1), a2 + hstep, voffA);
            PG8_WAIT_L(8); PG8_BAR; PG8_WAIT_L(0); PG8_MMA(0, 0, At, B0); PG8_BAR; PG8_SCHED;
            PG8_LDB(B1, 1, 1); PG8_STAGE(PG8_SB(1, 0), b3, voffB);
            PG8_BAR; PG8_WAIT_L(0); PG8_MMA(0, 1, At, B1); PG8_BAR;
            PG8_LDA(At, 1, 1); PG8_STAGE(PG8_SA(1, 0), a3, voffA);
            PG8_BAR; PG8_WAIT_L(0); PG8_MMA(1, 0, At, B0); PG8_BAR; PG8_SCHED;
            PG8_STAGE(PG8_SB(1, 1), b3 + hstep, voffB);
            PG8_WAIT_V(6); PG8_BAR; PG8_MMA(1, 1, At, B1); PG8_BAR;
            }
        }
        if constexpr (ALIGN_EPI) { if (wr == 0) PG8_BAR; }
        if constexpr (!Epi::AFTER_DRAIN) { E(acc, cur, wr, wc, fr, fq); S.done(cur); }
        if (!has_next) break;
#pragma unroll
        for (int a = 0; a < 2; ++a)
#pragma unroll
            for (int b = 0; b < 2; ++b)
#pragma unroll
                for (int m = 0; m < 4; ++m)
#pragma unroll
                    for (int n = 0; n < 2; ++n) acc[a][b][m][n] = (f32x4){0.f, 0.f, 0.f, 0.f};
        cur = nxt; cA = nA; cB = nB; ++ui;
        if constexpr (ALIGN_EPI) { if (wr == 1) PG8_BAR; }
    }
    PG8_WAIT_V(0);
    if constexpr (!ALIGN_EPI) { if (wr == 0) PG8_BAR; }
    PG8_BAR;
    if constexpr (Epi::AFTER_DRAIN) { E.fused(acc, cur, wr, wc, fr, fq, lds, wid, lane); S.done(cur); }
#undef PG8_SA
#undef PG8_SB
#undef PG8_STAGE
#undef PG8_LDA
#undef PG8_LDB
#undef PG8_MMA
#undef PG8_WAIT_V
#undef PG8_WAIT_L
#undef PG8_BAR
#undef PG8_SCHED
}
}

struct TileOrder {
    int nN, nU; bool xonly;
    DI bool next(int i, pg8::Unit& u) const {
        const int L = i * (int)gridDim.x + (int)blockIdx.x; if (L >= nU) return false;
        const int t = L / nN; u.pn = L - t * nN; u.pm = xonly ? t + 1 + (t >= 32 ? 1 : 0) : t; return true;
    }
    DI void a_ready(const pg8::Unit&) const {}
    DI void done(const pg8::Unit&) const {}
};

struct XTiles {
    int nFl, f0, nTl, t0, lb, nlb, count;
    DI XTiles(int nF, int nT) {
        const int x = blockIdx.x & 7; lb = blockIdx.x >> 3; nlb = gridDim.x >> 3;
        const int fg = x & 1, tg = x >> 1;
        nFl = nF >> 1; f0 = fg * nFl;
        const int q = nT >> 2, r = nT & 3;
        nTl = q + (tg < r ? 1 : 0); t0 = tg * q + (tg < r ? tg : r);
        count = nFl * nTl;
    }
    DI void get(int idx, int& ft, int& tt) const { ft = f0 + idx % nFl; tt = t0 + idx / nFl; }
};

template <class DMap>
DI void conv_tile(LAS float* sm, const float* src, int K, int N, bf16_t* dst, int k0, int n0, const float* kscale, DMap dmap) {
    const int tid = threadIdx.x;
    __syncthreads();
    for (int idx = tid; idx < 1024; idx += NTHR) {
        const int kr = idx >> 4, c4 = idx & 15;
        const int n = n0 + c4 * 4;
        f32x4 v = (f32x4){0.f, 0.f, 0.f, 0.f};
        if (n < N) v = *(const f32x4*)(src + (size_t)(k0 + kr) * N + n);
        const float s = kscale ? kscale[k0 + kr] : 1.f;
        sm[kr * 65 + c4 * 4 + 0] = v[0] * s; sm[kr * 65 + c4 * 4 + 1] = v[1] * s; sm[kr * 65 + c4 * 4 + 2] = v[2] * s; sm[kr * 65 + c4 * 4 + 3] = v[3] * s;
    }
    __syncthreads();
    for (int idx = tid; idx < 512; idx += NTHR) {
        const int nn = idx >> 3, kc = idx & 7;
        const int n = n0 + nn;
        if (n < N) {
            u32x4 w;
            w.x = pk2(sm[(kc * 8 + 0) * 65 + nn], sm[(kc * 8 + 1) * 65 + nn]);
            w.y = pk2(sm[(kc * 8 + 2) * 65 + nn], sm[(kc * 8 + 3) * 65 + nn]);
            w.z = pk2(sm[(kc * 8 + 4) * 65 + nn], sm[(kc * 8 + 5) * 65 + nn]);
            w.w = pk2(sm[(kc * 8 + 6) * 65 + nn], sm[(kc * 8 + 7) * 65 + nn]);
            *(u32x4*)(dst + (size_t)dmap(n) * K + k0 + kc * 8) = w;
        }
    }
}
struct IdMap { DI int operator()(int n) const { return n; } };
struct GrpMap { DI int operator()(int n) const { return grp_row(n); } };
struct OddMap {
    DI int col(int n) const {
        if (n < 384) return n;
        if (n < 416) return 1920 + (n - 384);
        if (n < 1440) return n - 32;
        if (n < 1456) return 1952 + (n - 1440);
        if (n < 1472) return 1968 + (n - 1456);
        return n - 64;
    }
    DI int operator()(int n) const { return grp_row(col(n)); }
};

DI void wsk_tile(const Params& p, LAS uchar* lds, int t) {
    const int tid = threadIdx.x, wave = __builtin_amdgcn_readfirstlane(tid >> 6), lane = tid & 63, r = lane & 31, h = lane >> 5, wf = wave >> 2, wt = wave & 3;
    const int l = t >> 7, g = (t >> 3) & 15, kt = t & 7;
    const float* wq = p.p_wq + (size_t)l * 1024 * 2048 + (size_t)kt * 128 * 2048 + g * 128;
    const float* ky = p.p_keys + ((size_t)l * 16 + g) * 128 * 128;
#pragma unroll
    for (int q = 0; q < 4; ++q) {
        const int i = tid + q * NTHR, row = i >> 4, c = i & 15;
        const f32x4 a = *(const f32x4*)(wq + (size_t)row * 2048 + c * 8), b = *(const f32x4*)(wq + (size_t)row * 2048 + c * 8 + 4);
        const f32x4 e = *(const f32x4*)(ky + (size_t)row * 128 + c * 8), f = *(const f32x4*)(ky + (size_t)row * 128 + c * 8 + 4);
        const unsigned off = (c >> 3) * 16384 + t128_off(row, c & 7);
        *(LAS u32x4*)(lds + off) = (u32x4){pk2(a[0], a[1]), pk2(a[2], a[3]), pk2(b[0], b[1]), pk2(b[2], b[3])};
        *(LAS u32x4*)(lds + 32768 + off) = (u32x4){pk2(e[0], e[1]), pk2(e[2], e[3]), pk2(f[0], f[1]), pk2(f[2], f[3])};
    }
    __syncthreads();
    f32x16 acc[2];
#pragma unroll
    for (int i = 0; i < 2; ++i)
#pragma unroll
        for (int e = 0; e < 16; ++e) acc[i][e] = 0.f;
#pragma unroll
    for (int dh = 0; dh < 2; ++dh)
#pragma unroll
        for (int kk = 0; kk < 4; ++kk) {
            const bf16x8 b = ldsfrag(lds + 32768 + dh * 16384, t128_off(wt * 32 + r, 2 * kk + h));
#pragma unroll
            for (int i = 0; i < 2; ++i) acc[i] = MFMA32(ldsfrag(lds + dh * 16384, t128_off(wf * 64 + i * 32 + r, 2 * kk + h)), b, acc[i]);
        }
    bf16_t* dst = (bf16_t*)(p.ws + OFF_PWQ) + (size_t)l * 2048 * 1024 + (size_t)(g * 128 + wt * 32 + r) * 1024 + kt * 128 + wf * 64;
#pragma unroll
    for (int i = 0; i < 2; ++i)
#pragma unroll
        for (int g4 = 0; g4 < 4; ++g4)
            *(u32x2*)(dst + i * 32 + 8 * g4 + 4 * h) = (u32x2){pk2(acc[i][4 * g4], acc[i][4 * g4 + 1]), pk2(acc[i][4 * g4 + 2], acc[i][4 * g4 + 3])};
    __syncthreads();
}

DI void phase_prep(const Params& p, LAS uchar* lds) {
    const int tid = threadIdx.x;
    uchar* ws = p.ws;
    {
        const int nt0 = 16 * 36, nt1 = 16 * 16, nt2 = 16 * 31, nt3 = 16 * 16, nt4 = 4 * 12, nt5 = 2 * 16;
        const int total = nt0 + nt1 + nt2 + nt3 + nt4 + nt5;
        for (int t = blockIdx.x; t < total; t += gridDim.x) {
            int u = t;
            LAS float* sm = (LAS float*)lds;
            if (u < nt0) { conv_tile(sm, p.e_w_in, 1024, 2304, (bf16_t*)(ws + OFF_WINE), (u % 16) * 64, (u / 16) * 64, nullptr, GrpMap()); continue; }
            u -= nt0;
            if (u < nt1) { conv_tile(sm, p.e_w_out, 1024, 1024, (bf16_t*)(ws + OFF_WOUTE), (u % 16) * 64, (u / 16) * 64, nullptr, IdMap()); continue; }
            u -= nt1;
            if (u < nt2) { conv_tile(sm, p.o_w_in, 1024, 1984, (bf16_t*)(ws + OFF_WINO), (u % 16) * 64, (u / 16) * 64, nullptr, OddMap()); continue; }
            u -= nt2;
            if (u < nt3) { conv_tile(sm, p.o_w_out, 1024, 1024, (bf16_t*)(ws + OFF_WOUTO), (u % 16) * 64, (u / 16) * 64, nullptr, IdMap()); continue; }
            u -= nt3;
            if (u < nt4) { conv_tile(sm, p.c_wq_up, 256, 768, (bf16_t*)(ws + OFF_WQUP), (u % 4) * 64, (u / 4) * 64, p.c_gq, IdMap()); continue; }
            u -= nt4;
            conv_tile(sm, p.c_wkv_up, 128, 1024, (bf16_t*)(ws + OFF_WKVUP), (u % 2) * 64, (u / 2) * 64, p.c_gkv, IdMap());
        }
        __syncthreads();
        for (int t = blockIdx.x; t < 256; t += gridDim.x) wsk_tile(p, lds, t);
    }
    const size_t gtid = (size_t)blockIdx.x * NTHR + tid, gsz = (size_t)gridDim.x * NTHR;
    for (size_t i = gtid; i < (size_t)64 * 1024 / 8; i += gsz) {
        const size_t hv = i / (32 * 1024 / 8), w = i % (32 * 1024 / 8);
        ((u32x4*)(ws + OFF_WINO + (size_t)(hv ? 2016 : 1888) * 1024 * 2))[w] = (u32x4){0u, 0u, 0u, 0u};
    }
    {
        const int kper = 1024 / KSPLIT;
        for (size_t t = gtid; t < (size_t)KSPLIT * 2 * 1536; t += gsz) {
            const int col4 = (int)(t % 1536), rem = (int)(t / 1536), layer = rem & 1, ks = rem >> 1;
            const float* W = p.w_mod + (size_t)layer * 1024 * 6144 + (size_t)(ks * kper) * 6144 + col4 * 4;
            f32x4 a0 = (f32x4){0.f, 0.f, 0.f, 0.f}, a1 = a0, a2 = a0;
#pragma unroll 8
            for (int kk = 0; kk < kper; ++kk) {
                const int k = ks * kper + kk;
                const f32x4 w = *(const f32x4*)(W + (size_t)kk * 6144);
                a0 += w * silu_f(p.c[k]); a1 += w * silu_f(p.c[1024 + k]); a2 += w * silu_f(p.c_ctx[k]);
            }
            float* mp = (float*)(ws + OFF_MODPART) + (size_t)(ks * 2 + layer) * 3 * 6144 + col4 * 4;
            *(f32x4*)(mp) = a0; *(f32x4*)(mp + 6144) = a1; *(f32x4*)(mp + 2 * 6144) = a2;
        }
    }
    for (size_t i = gtid; i < (size_t)8192 * 48; i += gsz) {
        const int pos = (int)(i / 48), j = (int)(i % 48);
        const float rr = (float)(pos / 64), cc = (float)(pos % 64);
        if (j < 32) {
            const int fi = j & 15;
            const float inv = 1.0f / powf(10000.0f, (float)(2 * fi) / 32.0f);
            const float ang = (j < 16 ? rr : cc) * inv;
            float s, c; sincosf(ang, &s, &c);
            ((f32x2*)(ws + OFF_ROPEAB))[(size_t)pos * 32 + j] = (f32x2){c, s};
        } else {
            const int jj = j - 32, fi = jj & 7;
            const float inv = 1.0f / powf(10000.0f, (float)(2 * fi) / 16.0f);
            const float ang = (jj < 8 ? rr : cc) * inv;
            float s, c; sincosf(ang, &s, &c);
            ((f32x2*)(ws + OFF_ROPEC))[(size_t)pos * 16 + jj] = (f32x2){c, s};
        }
    }
    if (gtid == 0) {
        float s1 = 0.f, s2 = 0.f;
        for (int i = 0; i < 64; ++i) { s1 += p.a_lq1[i] * p.a_lk1[i]; s2 += p.a_lq2[i] * p.a_lk2[i]; }
        ((float*)(ws + OFF_SCAL))[0] = expf(s1) - expf(s2) + 0.2f;
    }
}

DI void norm_row_store(const float* row, const float* g, const float* shift, const float* scale, bf16_t* dst, int lane, uchar* dst8 = nullptr) {
    f32x4 v[4]; float ss = 0.f;
#pragma unroll
    for (int j = 0; j < 4; ++j) { v[j] = *(const f32x4*)(row + 256 * j + 4 * lane); ss += v[j][0] * v[j][0] + v[j][1] * v[j][1] + v[j][2] * v[j][2] + v[j][3] * v[j][3]; }
    ss = wave_sum(ss);
    const float rstd = rsqrtf(ss * (1.0f / 1024.0f) + EPS);
#pragma unroll
    for (int j = 0; j < 4; ++j) {
        const int c0 = 256 * j + 4 * lane;
        const f32x4 gg = *(const f32x4*)(g + c0), sh = *(const f32x4*)(shift + c0), sc = *(const f32x4*)(scale + c0);
        const f32x4 y = v[j] * rstd * gg * (sc + 1.0f) + sh;
        u32x2 w; w.x = pk2(y[0], y[1]); w.y = pk2(y[2], y[3]);
        *(u32x2*)(dst + c0) = w;
        if (dst8) {
            int w8 = __builtin_amdgcn_cvt_pk_fp8_f32(y[0], y[1], 0, false);
            w8 = __builtin_amdgcn_cvt_pk_fp8_f32(y[2], y[3], w8, true);
            *(int*)(dst8 + c0) = w8;
        }
    }
}

DI void phase_norm1_l0(const Params& p, LAS uchar* lds) {
    const int tid = threadIdx.x, wave = __builtin_amdgcn_readfirstlane(tid >> 6), lane = tid & 63;
    LAS float* sm = (LAS float*)lds;
    const float* mpart = (const float*)(p.ws + OFF_MODPART);
    const int ntask = NT / 32, t0 = (int)((long)blockIdx.x * ntask / gridDim.x), t1 = (int)((long)(blockIdx.x + 1) * ntask / gridDim.x);
    int cur_mid = -1;
    for (int t = t0; t < t1; ++t) {
        const int tok0 = t * 32, mid = mod_id(tok0);
        if (mid != cur_mid) {
        cur_mid = mid;
        __syncthreads();
#pragma unroll
        for (int i = 0; i < 2048 / NTHR; ++i) {
            const int n = tid + i * NTHR;
            float part[KSPLIT];
#pragma unroll
            for (int ks = 0; ks < KSPLIT; ++ks) part[ks] = mpart[(size_t)((ks * 2 + 0) * 3 + mid) * 6144 + n];
            float s = p.b_mod[n];
#pragma unroll
            for (int ks = 0; ks < KSPLIT; ++ks) s += part[ks];
            sm[n] = s;
        }
        __syncthreads();
        }
        for (int rr = wave; rr < 32; rr += NW) {
            const int tok = tok0 + rr;
            const float* row = in_row(p, tok);
            f32x4 v[4]; float ss = 0.f;
#pragma unroll
            for (int j = 0; j < 4; ++j) { v[j] = *(const f32x4*)(row + 256 * j + 4 * lane); ss += v[j][0] * v[j][0] + v[j][1] * v[j][1] + v[j][2] * v[j][2] + v[j][3] * v[j][3]; }
            ss = wave_sum(ss);
            const float rstd = rsqrtf(ss * (1.0f / 1024.0f) + EPS);
            bf16_t* dst = (bf16_t*)(p.ws + OFF_HBF) + (size_t)tok * DM;
#pragma unroll
            for (int j = 0; j < 4; ++j) {
                const int c0 = 256 * j + 4 * lane;
                const f32x4 gg = *(const f32x4*)(p.norm1 + c0);
                f32x4 y;
#pragma unroll
                for (int e = 0; e < 4; ++e) y[e] = v[j][e] * rstd * gg[e] * (1.0f + sm[1024 + c0 + e]) + sm[c0 + e];
                u32x2 w; w.x = pk2(y[0], y[1]); w.y = pk2(y[2], y[3]);
                *(u32x2*)(dst + c0) = w;
            }
        }
    }
    float* mod = (float*)(p.ws + OFF_MOD);
    for (int e = blockIdx.x * NTHR + tid; e < 36864; e += gridDim.x * NTHR) {
        const int layer = e / 18432, rem = e % 18432, v = rem / 6144, n = rem % 6144;
        float part[KSPLIT];
#pragma unroll
        for (int ks = 0; ks < KSPLIT; ++ks) part[ks] = mpart[(size_t)((ks * 2 + layer) * 3 + v) * 6144 + n];
        float s = p.b_mod[layer * 6144 + n];
#pragma unroll
        for (int ks = 0; ks < KSPLIT; ++ks) s += part[ks];
        mod[e] = s;
    }
}

DI void phase_norm2(const Params& p, int layer, bool xonly) {
    const int tid = threadIdx.x, wave = __builtin_amdgcn_readfirstlane(tid >> 6), lane = tid & 63;
    if (layer == 0) {
        float* ssq64 = (float*)(p.ws + OFF_SSQ64);
        for (int i = blockIdx.x * NTHR + tid; i < NB * LCTX * 8; i += gridDim.x * NTHR) ssq64[(size_t)((i / (LCTX * 8)) * TPB) * 8 + (i % (LCTX * 8))] = 0.f;
    }
    const float* mod = (const float*)(p.ws + OFF_MOD);
    const int nrows = xonly ? NB * SEQ : NT;
    for (int rix = blockIdx.x * NW + wave; rix < nrows; rix += gridDim.x * NW) {
        const int tok = xonly ? (rix / SEQ) * TPB + LCTX + (rix % SEQ) : rix;
        const int mid = mod_id(tok);
        const float* mm = mod + (size_t)(layer * 3 + mid) * 6144;
        norm_row_store(res_row(p, tok), p.norm2 + layer * DM, mm + 3 * 1024, mm + 4 * 1024, (bf16_t*)(p.ws + OFF_HBF) + (size_t)tok * DM, lane, p.ws + OFF_H8 + (size_t)tok * DM);
    }
}

struct EpiInEven {
    static constexpr bool PERM = false, AFTER_DRAIN = false;
    const Params* pp;
    DI void operator()(const f32x4 (&acc)[2][2][4][2], const pg8::Unit& u, int wr, int wc, int fr, int fq) const {
        const Params& p = *pp;
        const int fw = u.pn * 256 + wc * 64;
        const bool isv = (fw >= 1024 && fw < 1536) || fw >= 2176;
        const f32x4* ropeab = (const f32x4*)(p.ws + OFF_ROPEAB);
        const float qs = 0.125f * LOG2E;
        const int tok00 = u.pm * 256 + wr * 64 + fr;
        if (!isv) {
            const float* gain; size_t dbase; float osc = 1.f; int hs, hm;
            int g;
            if (fw < 512) { g = fw >> 6; gain = p.a_qn; osc = qs; dbase = OFF_AQ; hs = 8; hm = ((g >> 1) * 2 + (g & 1)); }
            else if (fw < 1024) { g = (fw - 512) >> 6; gain = p.a_kn; dbase = OFF_AK; hs = 8; hm = ((g >> 1) * 2 + (g & 1)); }
            else if (fw < 2048) { g = (fw - 1536) >> 6; gain = p.b_qn; osc = qs; dbase = OFF_BQ; hs = 8; hm = g; }
            else { g = (fw - 2048) >> 6; gain = p.b_kn; dbase = OFF_BK; hs = 2; hm = g; }
            f32x4 gg[2][2];
#pragma unroll
            for (int bj = 0; bj < 2; ++bj)
#pragma unroll
                for (int n = 0; n < 2; ++n) gg[bj][n] = *(const f32x4*)(gain + 32 * bj + 16 * n + 4 * fq) * osc;
            f32x4 cs[2][2], csn[2][2];
            {
                const int ti = tok00 % TPB; const int pos = max(ti - LCTX, 0);
#pragma unroll
                for (int bj = 0; bj < 2; ++bj)
#pragma unroll
                    for (int n = 0; n < 2; ++n) csn[bj][n] = ropeab[(size_t)pos * 16 + 8 * bj + 4 * n + fq];
            }
#pragma unroll
            for (int ai = 0; ai < 2; ++ai)
#pragma unroll
                for (int m = 0; m < 4; ++m) {
                    const int tok = tok00 + ai * 128 + m * 16;
                    const int b = tok / TPB, ti = tok - b * TPB;
                    const bool isx = ti >= LCTX;
#pragma unroll
                    for (int bj = 0; bj < 2; ++bj)
#pragma unroll
                        for (int n = 0; n < 2; ++n) cs[bj][n] = csn[bj][n];
                    if (ai * 4 + m < 7) {
                        const int tokn = tok00 + ((ai * 4 + m + 1) >> 2) * 128 + ((ai * 4 + m + 1) & 3) * 16;
                        const int posn = max(tokn % TPB - LCTX, 0);
#pragma unroll
                        for (int bj = 0; bj < 2; ++bj)
#pragma unroll
                            for (int n = 0; n < 2; ++n) csn[bj][n] = ropeab[(size_t)posn * 16 + 8 * bj + 4 * n + fq];
                    }
                    float ss = 0.f;
#pragma unroll
                    for (int bj = 0; bj < 2; ++bj)
#pragma unroll
                        for (int n = 0; n < 2; ++n)
#pragma unroll
                            for (int e = 0; e < 4; ++e) ss += acc[ai][bj][m][n][e] * acc[ai][bj][m][n][e];
                    ss += __shfl_xor(ss, 16); ss += __shfl_xor(ss, 32);
                    const float rstd = rsqrtf(ss * (1.0f / 64.0f) + EPS);
                    bf16_t* dst = (bf16_t*)(p.ws + dbase) + ((size_t)(b * hs + hm) * TPB + ti) * 64;
#pragma unroll
                    for (int bj = 0; bj < 2; ++bj)
#pragma unroll
                        for (int n = 0; n < 2; ++n) {
                            const int d = 32 * bj + 16 * n + 4 * fq;
                            float y0 = acc[ai][bj][m][n][0] * rstd * gg[bj][n][0], y1 = acc[ai][bj][m][n][1] * rstd * gg[bj][n][1];
                            float y2 = acc[ai][bj][m][n][2] * rstd * gg[bj][n][2], y3 = acc[ai][bj][m][n][3] * rstd * gg[bj][n][3];
                            if (isx) {
                                const f32x4 c4 = cs[bj][n];
                                const float z0 = y0 * c4[0] - y1 * c4[1], z1 = y0 * c4[1] + y1 * c4[0];
                                const float z2 = y2 * c4[2] - y3 * c4[3], z3 = y2 * c4[3] + y3 * c4[2];
                                y0 = z0; y1 = z1; y2 = z2; y3 = z3;
                            }
                            *(u32x2*)(dst + d) = (u32x2){pk2(y0, y1), pk2(y2, y3)};
                        }
                }
        } else {
#pragma unroll
            for (int ai = 0; ai < 2; ++ai)
#pragma unroll
                for (int m = 0; m < 4; ++m) {
                    const int tok = tok00 + ai * 128 + m * 16;
                    const int b = tok / TPB, ti = tok - b * TPB;
                    bf16_t* dst; int dvb;
                    if (fw < 1536) { const int hd = (fw - 1024) >> 7; dvb = (fw - 1024) & 127; dst = (bf16_t*)(p.ws + OFF_AVT) + (size_t)(b * 4 + hd) * 128 * TPB; }
                    else { const int hd = (fw - 2176) >> 6; dvb = 0; dst = (bf16_t*)(p.ws + OFF_BVT) + (size_t)(b * 2 + hd) * 64 * TPB; }
                    const int tp = perm16(ti);
#pragma unroll
                    for (int bj = 0; bj < 2; ++bj)
#pragma unroll
                        for (int n = 0; n < 2; ++n)
#pragma unroll
                            for (int e = 0; e < 4; ++e) dst[(size_t)(dvb + 32 * bj + 16 * n + 4 * fq + e) * TPB + tp] = f2bf(acc[ai][bj][m][n][e]);
                }
        }
    }
};
DI void inproj_even_tile(const Params& p, LAS uchar* lds, int ft, int tt) {
    const int tid = threadIdx.x, wave = __builtin_amdgcn_readfirstlane(tid >> 6), lane = tid & 63, r = lane & 31, h = lane >> 5, wf = wave >> 2, wt = wave & 3;
    const bf16_t* X = (const bf16_t*)(p.ws + OFF_HBF);
    const f32x4* ropeab = (const f32x4*)(p.ws + OFF_ROPEAB);
    f32x16 acc[2][2];
    gemm_block<2, 2, 3, RowGrp>(lds, (const bf16_t*)(p.ws + OFF_WINE), 1024, X + (size_t)tt * 256 * 1024, 1024, 1024, acc, RowGrp{ft * 128});
    const int fw = ft * 128 + wf * 64;
#pragma unroll
    for (int j = 0; j < 2; ++j) {
        const int tok = tt * 256 + wt * 64 + j * 32 + r;
        const int b = tok / TPB, ti = tok - b * TPB;
        const bool isx = ti >= LCTX; const int pos = ti - LCTX;
        const bool isv = (fw >= 1024 && fw < 1536) || fw >= 2176;
        if (!isv) {
            float ss = 0.f;
#pragma unroll
            for (int i = 0; i < 2; ++i)
#pragma unroll
                for (int e = 0; e < 16; ++e) ss += acc[i][j][e] * acc[i][j][e];
            ss += __shfl_xor(ss, 32);
            const float rstd = rsqrtf(ss * (1.0f / 64.0f) + EPS);
            const float* gain; bf16_t* dst; float osc = 1.f;
            const float qs = 0.125f * LOG2E;
            if (fw < 512) { const int g = fw >> 6; gain = p.a_qn; osc = qs; dst = (bf16_t*)(p.ws + OFF_AQ) + ((size_t)(b * 4 + (g >> 1)) * 2 + (g & 1)) * TPB * 64; }
            else if (fw < 1024) { const int g = (fw - 512) >> 6; gain = p.a_kn; dst = (bf16_t*)(p.ws + OFF_AK) + ((size_t)(b * 4 + (g >> 1)) * 2 + (g & 1)) * TPB * 64; }
            else if (fw < 2048) { const int g = (fw - 1536) >> 6; gain = p.b_qn; osc = qs; dst = (bf16_t*)(p.ws + OFF_BQ) + (size_t)(b * 8 + g) * TPB * 64; }
            else { const int g = (fw - 2048) >> 6; gain = p.b_kn; dst = (bf16_t*)(p.ws + OFF_BK) + (size_t)(b * 2 + g) * TPB * 64; }
            dst += (size_t)ti * 64;
#pragma unroll
            for (int i = 0; i < 2; ++i)
#pragma unroll
                for (int g4 = 0; g4 < 4; ++g4) {
                    const int d = i * 32 + 8 * g4 + 4 * h;
                    const f32x4 gg = *(const f32x4*)(gain + d);
                    float y0 = acc[i][j][4 * g4 + 0] * rstd * gg[0], y1 = acc[i][j][4 * g4 + 1] * rstd * gg[1];
                    float y2 = acc[i][j][4 * g4 + 2] * rstd * gg[2], y3 = acc[i][j][4 * g4 + 3] * rstd * gg[3];
                    if (isx) {
                        const f32x4 cs = ropeab[((size_t)pos * 32 + (d >> 1)) >> 1];
                        const float z0 = y0 * cs[0] - y1 * cs[1], z1 = y0 * cs[1] + y1 * cs[0];
                        const float z2 = y2 * cs[2] - y3 * cs[3], z3 = y2 * cs[3] + y3 * cs[2];
                        y0 = z0; y1 = z1; y2 = z2; y3 = z3;
                    }
                    u32x2 w; w.x = pk2(y0 * osc, y1 * osc); w.y = pk2(y2 * osc, y3 * osc);
                    *(u32x2*)(dst + d) = w;
                }
        } else {
            const int tl = perm16(wt * 64 + j * 32 + r);
#pragma unroll
            for (int i = 0; i < 2; ++i)
#pragma unroll
                for (int e = 0; e < 16; ++e) *(LAS bf16_t*)(lds + (wf * 64 + i * 32 + crow(e, h)) * 512 + tl * 2) = f2bf(acc[i][j][e]);
        }
    }
    if (ft * 128 >= 1024 && (ft * 128 < 1536 || ft * 128 >= 2176)) {
        __syncthreads();
        const int tok0 = tt * 256, b = tok0 / TPB, ti0 = tok0 - b * TPB;
        for (int idx = tid; idx < 128 * 32; idx += NTHR) {
            const int row = idx >> 5, pc = idx & 31;
            const int f = ft * 128 + row;
            bf16_t* dst;
            if (f < 1536) dst = (bf16_t*)(p.ws + OFF_AVT) + ((size_t)(b * 4 + ((f - 1024) >> 7)) * 128 + ((f - 1024) & 127)) * TPB;
            else dst = (bf16_t*)(p.ws + OFF_BVT) + ((size_t)(b * 2 + ((f - 2176) >> 6)) * 64 + ((f - 2176) & 63)) * TPB;
            *(u32x4*)(dst + ti0 + pc * 8) = *(const LAS u32x4*)(lds + row * 512 + pc * 16);
        }
        __syncthreads();
    }
}
DI void phase_inproj_even(const Params& p, LAS uchar* lds) {
    const pg8::Gemm g{(const bf16_t*)(p.ws + OFF_HBF), (const bf16_t*)(p.ws + OFF_WINE), NT, 2304, 1024};
    const TileOrder S{8, 8 * NB * 32, true};
    const EpiInEven E{&p};
    pg8::gemm_phase<EpiInEven, TileOrder, true, true>(lds, g, S, E);
    for (int t = blockIdx.x; t < 164; t += gridDim.x) {
        int ft, tt;
        if (t < 132) { ft = 16 + (t & 1); tt = t >> 1; }
        else { const int u = t - 132; ft = u & 15; tt = (u >> 4) ? TPB / 256 : 0; }
        inproj_even_tile(p, lds, ft, tt);
    }
}

template <int NSUB, bool ROPE, int DVT, bool MASK>
DI void attn_core(LAS uchar* lds, const bf16_t* const (&qw)[NSUB], const bf16_t* qrw, const bf16_t* const (&kb)[NSUB], const bf16_t* krb,
                  const bf16_t* vtb, int ra0, int ra1, int rb0, int rb1, int qx, f32x16 (&O)[NSUB][DVT], float (&l)[NSUB]) {
    constexpr int KOFF_R = NSUB * 8192, VOFF = KOFF_R + (ROPE ? 4096 : 0), STG = VOFF + DVT * 4096;
    constexpr int NST = 4, NDMA = NSUB + (ROPE ? 1 : 0) + DVT / 2;
    const int tid = threadIdx.x, wave = __builtin_amdgcn_readfirstlane(tid >> 6), lane = tid & 63, r = lane & 31, h = lane >> 5;
    bf16x8 qf[NSUB][4]; bf16x8 qrf[2];
#pragma unroll
    for (int s = 0; s < NSUB; ++s)
#pragma unroll
        for (int kk = 0; kk < 4; ++kk) qf[s][kk] = *(const bf16x8*)(qw[s] + r * 64 + kk * 16 + h * 8);
    if (ROPE) {
#pragma unroll
        for (int kk = 0; kk < 2; ++kk) qrf[kk] = *(const bf16x8*)(qrw + r * 32 + kk * 16 + h * 8);
    }
#pragma unroll
    for (int s = 0; s < NSUB; ++s) {
        l[s] = 0.f;
#pragma unroll
        for (int d = 0; d < DVT; ++d)
#pragma unroll
            for (int e = 0; e < 16; ++e) O[s][d][e] = 0.f;
    }
    const int na = ra1 - ra0, ntile = na + (rb1 - rb0);
    auto issue = [&](int it, int stg) {
        const int kt64 = it < na ? ra0 + it : rb0 + (it - na);
        LAS uchar* st = lds + stg * STG;
#pragma unroll
        for (int s = 0; s < NSUB; ++s) dma_t128(st + s * 8192, (const uchar*)(kb[s] + (size_t)kt64 * 64 * 64), 128, 64, wave, lane);
        if (ROPE) dma_t64(st + KOFF_R, (const uchar*)(krb + (size_t)kt64 * 64 * 32), 64, wave, lane);
        dma_t128(st + VOFF, (const uchar*)(vtb + (size_t)kt64 * 64), (size_t)TPB * 2, DVT * 32, wave, lane);
    };
    WAIT_VM0();
    __syncthreads();
#pragma unroll
    for (int s0 = 0; s0 < NST - 1; ++s0) if (s0 < ntile) issue(s0, s0);
    int cs = 0, is = NST - 1;
    for (int it = 0; it < ntile; ++it) {
        if (it + NST - 2 < ntile) wait_vmcnt<(NST - 2) * NDMA>(); else wait_vmcnt<0>();
        RAW_BAR();
        if (it + NST - 1 < ntile) issue(it + NST - 1, is);
        const LAS uchar* st = lds + cs * STG;
        cs = cs + 1 == NST ? 0 : cs + 1; is = is + 1 == NST ? 0 : is + 1;
        const int kt64 = it < na ? ra0 + it : rb0 + (it - na);
        const bool domask = MASK && (it >= na);
#pragma unroll
        for (int kt = 0; kt < 2; ++kt) {
            bf16x8 pk[NSUB][2];
#pragma unroll
            for (int s = 0; s < NSUB; ++s) {
                f32x16 S;
#pragma unroll
                for (int e = 0; e < 16; ++e) S[e] = 0.f;
#pragma unroll
                for (int kk = 0; kk < 4; ++kk) S = MFMA32(ldsfrag(st + s * 8192, t128_off(kt * 32 + r, 2 * kk + h)), qf[s][kk], S);
                if (ROPE) {
#pragma unroll
                    for (int kk = 0; kk < 2; ++kk) S = MFMA32(ldsfrag(st + KOFF_R, t64_off(kt * 32 + r, 2 * kk + h)), qrf[kk], S);
                }
                float ls = 0.f;
#pragma unroll
                for (int s2 = 0; s2 < 2; ++s2) {
                    float pe[8];
#pragma unroll
                    for (int e = 0; e < 8; ++e) {
                        float pv = __builtin_amdgcn_exp2f(S[8 * s2 + e]);
                        if (MASK) {
                            if (domask) {
                                const int kx = kt64 * 64 + kt * 32 + crow(8 * s2 + e, h) - LCTX;
                                const int dd = kx - qx;
                                if (dd > 128 || dd < -128) pv = 0.f;
                            }
                        }
                        pe[e] = pv; ls += pv;
                    }
                    u32x4 w;
                    w.x = pk2(pe[0], pe[1]); w.y = pk2(pe[2], pe[3]); w.z = pk2(pe[4], pe[5]); w.w = pk2(pe[6], pe[7]);
                    pk[s][s2] = __builtin_bit_cast(bf16x8, w);
                }
                l[s] += ls;
            }
#pragma unroll
            for (int d = 0; d < DVT; ++d)
#pragma unroll
                for (int s2 = 0; s2 < 2; ++s2) {
                    const bf16x8 vf = ldsfrag(st + VOFF, t128_off(d * 32 + r, 2 * (2 * kt + s2) + h));
#pragma unroll
                    for (int s = 0; s < NSUB; ++s) O[s][d] = MFMA32(vf, pk[s][s2], O[s][d]);
                }
        }
    }
#pragma unroll
    for (int s = 0; s < NSUB; ++s) l[s] += __shfl_xor(l[s], 32);
}

template <bool ROPE, int DVT, bool MASK = false>
DI void attn_core_q2(LAS uchar* lds, const bf16_t* qw, const bf16_t* qrw, const bf16_t* kb, const bf16_t* krb, const bf16_t* vtb, int na,
                     f32x16 (&O)[2][DVT], float (&l)[2], int rb0 = 0, int rb1 = 0, int qx = 0) {
    const int ntile = na + (rb1 - rb0);
    constexpr int KOFF_R = 8192, VOFF = KOFF_R + (ROPE ? 4096 : 0), STG = VOFF + DVT * 4096;
    constexpr int NST = 4, NDMA = 1 + (ROPE ? 1 : 0) + DVT / 2;
    const int tid = threadIdx.x, wave = __builtin_amdgcn_readfirstlane(tid >> 6), lane = tid & 63, r = lane & 31, h = lane >> 5;
    bf16x8 qf[2][4]; bf16x8 qrf[2][2];
#pragma unroll
    for (int g = 0; g < 2; ++g) {
#pragma unroll
        for (int kk = 0; kk < 4; ++kk) qf[g][kk] = *(const bf16x8*)(qw + (g * 32 + r) * 64 + kk * 16 + h * 8);
        if (ROPE) {
#pragma unroll
            for (int kk = 0; kk < 2; ++kk) qrf[g][kk] = *(const bf16x8*)(qrw + (g * 32 + r) * 32 + kk * 16 + h * 8);
        }
        l[g] = 0.f;
#pragma unroll
        for (int d = 0; d < DVT; ++d)
#pragma unroll
            for (int e = 0; e < 16; ++e) O[g][d][e] = 0.f;
    }
    auto issue = [&](int it, int stg) {
        const int kt64 = it < na ? it : rb0 + (it - na);
        LAS uchar* st = lds + stg * STG;
        dma_t128(st, (const uchar*)(kb + (size_t)kt64 * 64 * 64), 128, 64, wave, lane);
        if (ROPE) dma_t64(st + KOFF_R, (const uchar*)(krb + (size_t)kt64 * 64 * 32), 64, wave, lane);
        dma_t128(st + VOFF, (const uchar*)(vtb + (size_t)kt64 * 64), (size_t)TPB * 2, DVT * 32, wave, lane);
    };
    WAIT_VM0();
    __syncthreads();
#pragma unroll
    for (int s0 = 0; s0 < NST - 1; ++s0) if (s0 < ntile) issue(s0, s0);
    int cs = 0, is = NST - 1;
    for (int it = 0; it < ntile; ++it) {
        if (it + NST - 2 < ntile) wait_vmcnt<(NST - 2) * NDMA>(); else wait_vmcnt<0>();
        RAW_BAR();
        if (it + NST - 1 < ntile) issue(it + NST - 1, is);
        const LAS uchar* st = lds + cs * STG;
        cs = cs + 1 == NST ? 0 : cs + 1; is = is + 1 == NST ? 0 : is + 1;
#pragma unroll
        for (int kt = 0; kt < 2; ++kt) {
            f32x16 S[2];
#pragma unroll
            for (int g = 0; g < 2; ++g)
#pragma unroll
                for (int e = 0; e < 16; ++e) S[g][e] = 0.f;
#pragma unroll
            for (int kk = 0; kk < 4; ++kk) {
                const bf16x8 a = ldsfrag(st, t128_off(kt * 32 + r, 2 * kk + h));
#pragma unroll
                for (int g = 0; g < 2; ++g) S[g] = MFMA32(a, qf[g][kk], S[g]);
            }
            if (ROPE) {
#pragma unroll
                for (int kk = 0; kk < 2; ++kk) {
                    const bf16x8 a = ldsfrag(st + KOFF_R, t64_off(kt * 32 + r, 2 * kk + h));
#pragma unroll
                    for (int g = 0; g < 2; ++g) S[g] = MFMA32(a, qrf[g][kk], S[g]);
                }
            }
            bf16x8 pk[2][2];
#pragma unroll
            for (int g = 0; g < 2; ++g) {
                float ls = 0.f;
#pragma unroll
                for (int s2 = 0; s2 < 2; ++s2) {
                    float pe[8];
#pragma unroll
                    for (int e = 0; e < 8; ++e) {
                        float pv = __builtin_amdgcn_exp2f(S[g][8 * s2 + e]);
                        if (MASK) {
                            if (it >= na) {
                                const int kx = (rb0 + (it - na)) * 64 + kt * 32 + crow(8 * s2 + e, h) - LCTX;
                                const int dd = kx - (qx + g * 32);
                                if (dd > 128 || dd < -128) pv = 0.f;
                            }
                        }
                        pe[e] = pv; ls += pv;
                    }
                    u32x4 w;
                    w.x = pk2(pe[0], pe[1]); w.y = pk2(pe[2], pe[3]); w.z = pk2(pe[4], pe[5]); w.w = pk2(pe[6], pe[7]);
                    pk[g][s2] = __builtin_bit_cast(bf16x8, w);
                }
                l[g] += ls;
            }
#pragma unroll
            for (int d = 0; d < DVT; ++d)
#pragma unroll
                for (int s2 = 0; s2 < 2; ++s2) {
                    const bf16x8 vf = ldsfrag(st + VOFF, t128_off(d * 32 + r, 2 * (2 * kt + s2) + h));
#pragma unroll
                    for (int g = 0; g < 2; ++g) O[g][d] = MFMA32(vf, pk[g][s2], O[g][d]);
                }
        }
    }
#pragma unroll
    for (int g = 0; g < 2; ++g) l[g] += __shfl_xor(l[g], 32);
}

DI void conv_tables_dyn(const Params& p, LAS uchar* lds, int layer) {
    const int tid = threadIdx.x;
    volatile LAS unsigned* xst = (volatile LAS unsigned*)(lds + LDS_BYTES - 16);
    unsigned* ctr = (unsigned*)(p.ws + OFF_BAR) + 3584 + 64 * layer;
    constexpr unsigned n32 = 16384 * 1024 / 32, CH = 4096, NCH = 2 * n32 / CH;
    const float* pu = p.p_u + (size_t)layer * 16384 * 1024;
    const float* pv = p.p_v + (size_t)layer * 16384 * 1024;
    for (;;) {
        __syncthreads();
        if (tid == 0) xst[2] = __hip_atomic_fetch_add(ctr, 1u, __ATOMIC_RELAXED, __HIP_MEMORY_SCOPE_AGENT);
        __syncthreads();
        const unsigned c = xst[2];
        if (c >= NCH) break;
#pragma unroll 2
        for (unsigned q = 0; q < CH / NTHR; ++q) {
            const unsigned i = c * CH + q * NTHR + tid;
            const bool isu = i < n32; const unsigned j = isu ? i : i - n32;
            const f32x4* src = (const f32x4*)(isu ? pu : pv) + 8 * (size_t)j;
            const float sc = isu ? 64.0f : 2.0f;
            u32x4 w;
#pragma unroll
            for (int qq = 0; qq < 4; ++qq) {
                const f32x4 a = src[2 * qq], b = src[2 * qq + 1];
                unsigned d = 0;
                d = __builtin_amdgcn_cvt_scalef32_pk_fp4_f32(d, fminf(fmaxf(a[0] * sc, -6.f), 6.f), fminf(fmaxf(a[1] * sc, -6.f), 6.f), 1.0f, 0);
                d = __builtin_amdgcn_cvt_scalef32_pk_fp4_f32(d, fminf(fmaxf(a[2] * sc, -6.f), 6.f), fminf(fmaxf(a[3] * sc, -6.f), 6.f), 1.0f, 1);
                d = __builtin_amdgcn_cvt_scalef32_pk_fp4_f32(d, fminf(fmaxf(b[0] * sc, -6.f), 6.f), fminf(fmaxf(b[1] * sc, -6.f), 6.f), 1.0f, 2);
                d = __builtin_amdgcn_cvt_scalef32_pk_fp4_f32(d, fminf(fmaxf(b[2] * sc, -6.f), 6.f), fminf(fmaxf(b[3] * sc, -6.f), 6.f), 1.0f, 3);
                w[qq] = d;
            }
            ((u32x4*)(p.ws + (isu ? OFF_PU : OFF_PV) + (size_t)layer * 16384 * 512))[j] = w;
        }
    }
}

DI void phase_attn_l0(const Params& p, LAS uchar* lds) {
    const int tid = threadIdx.x, wave = __builtin_amdgcn_readfirstlane(tid >> 6), lane = tid & 63, r = lane & 31, h = lane >> 5;
    const float lam = ((const float*)(p.ws + OFF_SCAL))[0];
    bf16_t* aout = (bf16_t*)(p.ws + OFF_AOUT);
    const int xcd = blockIdx.x & 7, lb = blockIdx.x >> 3, nlb = gridDim.x >> 3;
    const int nA = (32 - lb + nlb - 1) / nlb, nB = (32 - lb + nlb - 1) / nlb, nAc = lb < 1 ? 1 : 0, nBc = lb < 1 ? 1 : 0;
    for (int it = 0; it < nA + nB + nAc + nBc; ++it) {
        if (it < nA || (it >= nA + nB && it < nA + nB + nAc)) {
            const int b = xcd >> 2, hd = xcd & 3; int q0, ra1;
            if (it < nA) { q0 = LCTX + (lb + it * nlb) * 256; ra1 = NCHUNK; }
            else { q0 = 0; ra1 = LCTX / 64; }
            const bf16_t* qb = (const bf16_t*)(p.ws + OFF_AQ) + (size_t)(b * 4 + hd) * 2 * TPB * 64;
            const bf16_t* kbp = (const bf16_t*)(p.ws + OFF_AK) + (size_t)(b * 4 + hd) * 2 * TPB * 64;
            const bf16_t* vtb = (const bf16_t*)(p.ws + OFF_AVT) + (size_t)(b * 4 + hd) * 128 * TPB;
            f32x16 O[1][4]; float l[1];
            const int tok = b * TPB + q0 + wave * 32 + r;
            bf16_t* dst = aout + (size_t)tok * DM + hd * 128;
            {
                const bf16_t* qw[1] = {qb + (size_t)(q0 + wave * 32) * 64};
                const bf16_t* kb[1] = {kbp};
                attn_core<1, false, 4, false>(lds, qw, nullptr, kb, nullptr, vtb, 0, ra1, 0, 0, 0, O, l);
                const float i0 = 1.0f / l[0];
#pragma unroll
                for (int d = 0; d < 4; ++d)
#pragma unroll
                    for (int g4 = 0; g4 < 4; ++g4)
                        *(u32x2*)(dst + d * 32 + 8 * g4 + 4 * h) = (u32x2){pk2(O[0][d][4 * g4] * i0, O[0][d][4 * g4 + 1] * i0), pk2(O[0][d][4 * g4 + 2] * i0, O[0][d][4 * g4 + 3] * i0)};
            }
            {
                const bf16_t* qw[1] = {qb + (size_t)TPB * 64 + (size_t)(q0 + wave * 32) * 64};
                const bf16_t* kb[1] = {kbp + (size_t)TPB * 64};
                attn_core<1, false, 4, false>(lds, qw, nullptr, kb, nullptr, vtb, 0, ra1, 0, 0, 0, O, l);
            }
            const float i1 = lam / l[0];
            float ss = 0.f;
#pragma unroll
            for (int d = 0; d < 4; ++d)
#pragma unroll
                for (int g4 = 0; g4 < 4; ++g4) {
                    const u32x2 o1 = __builtin_nontemporal_load((const u32x2*)(dst + d * 32 + 8 * g4 + 4 * h));
                    const float a0 = bflo(o1.x) - O[0][d][4 * g4] * i1, a1 = bfhi(o1.x) - O[0][d][4 * g4 + 1] * i1;
                    const float a2 = bflo(o1.y) - O[0][d][4 * g4 + 2] * i1, a3 = bfhi(o1.y) - O[0][d][4 * g4 + 3] * i1;
                    O[0][d][4 * g4] = a0; O[0][d][4 * g4 + 1] = a1; O[0][d][4 * g4 + 2] = a2; O[0][d][4 * g4 + 3] = a3;
                    ss += a0 * a0 + a1 * a1 + a2 * a2 + a3 * a3;
                }
            ss += __shfl_xor(ss, 32);
            const float rstd = rsqrtf(ss * (1.0f / 128.0f) + EPS) * 0.8f;
#pragma unroll
            for (int d = 0; d < 4; ++d)
#pragma unroll
                for (int g4 = 0; g4 < 4; ++g4) {
                    const int dv = d * 32 + 8 * g4 + 4 * h;
                    const f32x4 gg = *(const f32x4*)(p.a_gn + dv);
                    u32x2 w; w.x = pk2(O[0][d][4 * g4] * rstd * gg[0], O[0][d][4 * g4 + 1] * rstd * gg[1]);
                    w.y = pk2(O[0][d][4 * g4 + 2] * rstd * gg[2], O[0][d][4 * g4 + 3] * rstd * gg[3]);
                    *(u32x2*)(dst + dv) = w;
                }
        } else {
#ifndef NO_B_UNIT
            const int b = xcd >> 2, kvh = (xcd >> 1) & 1; int q0, rb0, rb1;
            if (it < nA + nB) {
                const int qx0 = ((xcd & 1) * 32 + lb + (it - nA) * nlb) * 128; q0 = LCTX + qx0;
                const int lo = qx0 - 128 < 0 ? 0 : qx0 - 128, hi = qx0 + 255 > SEQ - 1 ? SEQ - 1 : qx0 + 255;
                rb0 = lo / 64 + 4; rb1 = hi / 64 + 5;
            } else { q0 = (xcd & 1) * 128; rb0 = 0; rb1 = 0; }
            q0 += (wave >> 2) * 64;
            const int hq = kvh * 4 + (wave & 3);
            const bf16_t* qw = (const bf16_t*)(p.ws + OFF_BQ) + (size_t)(b * 8 + hq) * TPB * 64 + (size_t)q0 * 64;
            const bf16_t* kb = (const bf16_t*)(p.ws + OFF_BK) + (size_t)(b * 2 + kvh) * TPB * 64;
            const bf16_t* vtb = (const bf16_t*)(p.ws + OFF_BVT) + (size_t)(b * 2 + kvh) * 64 * TPB;
            f32x16 O[2][2]; float l[2];
            attn_core_q2<false, 2, true>(lds, qw, nullptr, kb, nullptr, vtb, LCTX / 64, O, l, rb0, rb1, q0 - LCTX + r);
            const float snk = __builtin_amdgcn_exp2f(p.b_sink[hq] * LOG2E);
#pragma unroll
            for (int g = 0; g < 2; ++g) {
                const float inv = 1.0f / (l[g] + snk);
                const int tok = b * TPB + q0 + g * 32 + r;
                bf16_t* dst = aout + (size_t)tok * DM + 512 + hq * 64;
#pragma unroll
                for (int d = 0; d < 2; ++d)
#pragma unroll
                    for (int g4 = 0; g4 < 4; ++g4) {
                        const int dv = d * 32 + 8 * g4 + 4 * h;
                        u32x2 w; w.x = pk2(O[g][d][4 * g4] * inv, O[g][d][4 * g4 + 1] * inv); w.y = pk2(O[g][d][4 * g4 + 2] * inv, O[g][d][4 * g4 + 3] * inv);
                        *(u32x2*)(dst + dv) = w;
                    }
            }
#endif
        }
    }
}

DI void phase_outproj_ctx(const Params& p, LAS uchar* lds, int layer, size_t woff);
struct EpiOutProj {
    static constexpr bool PERM = false, AFTER_DRAIN = false;
    const Params* pp; int layer;
    DI void operator()(const f32x4 (&acc)[2][2][4][2], const pg8::Unit& u, int wr, int wc, int fr, int fq) const {
        const Params& p = *pp;
        const float* mod = (const float*)(p.ws + OFF_MOD);
        const int col0 = u.pn * 256 + wc * 32 + 4 * fq;
#pragma unroll
        for (int ai = 0; ai < 2; ++ai)
#pragma unroll
            for (int m = 0; m < 4; ++m) {
                const int tok = u.pm * 256 + ai * 128 + wr * 64 + m * 16 + fr;
                const int mid = mod_id(tok);
                const float* gate = mod + (size_t)(layer * 3 + mid) * 6144 + 2 * 1024 + col0;
                const float* rin = (layer == 0 ? in_row(p, tok) : res_row(p, tok)) + col0;
                float* rout = res_row(p, tok) + col0;
#pragma unroll
                for (int bj = 0; bj < 2; ++bj)
#pragma unroll
                    for (int n = 0; n < 2; ++n) {
                        const int o = bj * 128 + n * 16;
                        const f32x4 gg = *(const f32x4*)(gate + o), xi = *(const f32x4*)(rin + o);
                        *(f32x4*)(rout + o) = xi + gg * acc[ai][bj][m][n];
                    }
            }
    }
};
DI void phase_outproj(const Params& p, LAS uchar* lds, int layer, size_t woff, bool xonly) {
    const pg8::Gemm g{(const bf16_t*)(p.ws + OFF_AOUT), (const bf16_t*)(p.ws + woff), NT, 1024, 1024};
    const TileOrder S{4, 4 * NB * 32, true};
    const EpiOutProj E{&p, layer};
    pg8::gemm_phase<EpiOutProj, TileOrder, true, true>(lds, g, S, E);
    if (!xonly) phase_outproj_ctx(p, lds, layer, woff);
}

DI void phase_outproj_ctx(const Params& p, LAS uchar* lds, int layer, size_t woff) {
    const int tid = threadIdx.x, wave = __builtin_amdgcn_readfirstlane(tid >> 6), lane = tid & 63, r = lane & 31, h = lane >> 5, wf = wave >> 2, wt = wave & 3;
    const bf16_t* Wt = (const bf16_t*)(p.ws + woff);
    const bf16_t* X = (const bf16_t*)(p.ws + OFF_AOUT);
    const float* mod = (const float*)(p.ws + OFF_MOD);
    const int nF = 16;
    for (int t = blockIdx.x; t < nF * NB; t += gridDim.x) {
        const int ft = t % nF, tok0 = (t / nF) * TPB;
        f32x16 acc[1][2];
        gemm_block<1, 2, 3>(lds, Wt + (size_t)ft * 64 * 1024, 1024, X + (size_t)tok0 * 1024, 1024, 1024, acc);
#pragma unroll
        for (int j = 0; j < 2; ++j) {
            const int tok = tok0 + wt * 64 + j * 32 + r;
            const int mid = mod_id(tok);
            const float* gate = mod + (size_t)(layer * 3 + mid) * 6144 + 2 * 1024;
            const float* rin = layer == 0 ? in_row(p, tok) : res_row(p, tok);
            float* rout = res_row(p, tok);
#pragma unroll
            for (int g4 = 0; g4 < 4; ++g4) {
                const int f = ft * 64 + wf * 32 + 8 * g4 + 4 * h;
                const f32x4 gg = *(const f32x4*)(gate + f), xi = *(const f32x4*)(rin + f);
                f32x4 o;
#pragma unroll
                for (int e = 0; e < 4; ++e) o[e] = xi[e] + gg[e] * acc[0][j][4 * g4 + e];
                *(f32x4*)(rout + f) = o;
            }
        }
    }
}

struct EpiPQ {
    static constexpr bool PERM = true, AFTER_DRAIN = false;
    bf16_t* O;
    DI void operator()(const f32x4 (&acc)[2][2][4][2], const pg8::Unit& u, int wr, int wc, int fr, int fq) const {
        const int col0 = u.pn * 256 + wc * 32 + 8 * fq;
#pragma unroll
        for (int ai = 0; ai < 2; ++ai)
#pragma unroll
            for (int m = 0; m < 4; ++m) {
                bf16_t* rowp = O + (size_t)(u.pm * 256 + ai * 128 + wr * 64 + m * 16 + fr) * 2048 + col0;
#pragma unroll
                for (int bj = 0; bj < 2; ++bj) {
                    const f32x4 v0 = acc[ai][bj][m][0], v1 = acc[ai][bj][m][1];
                    *(u32x4*)(rowp + bj * 128) = (u32x4){pk2(v0[0], v0[1]), pk2(v0[2], v0[3]), pk2(v1[0], v1[1]), pk2(v1[2], v1[3])};
                }
            }
    }
};
DI void phase_peer_pq_ctx(const Params& p, LAS uchar* lds, int layer) {
    const int tid = threadIdx.x, wave = __builtin_amdgcn_readfirstlane(tid >> 6), lane = tid & 63, r = lane & 31, h = lane >> 5, wf = wave >> 2, wt = wave & 3;
    const bf16_t* Wt = (const bf16_t*)(p.ws + OFF_PWQ) + (size_t)layer * 2048 * 1024;
    const bf16_t* X = (const bf16_t*)(p.ws + OFF_HBF);
    bf16_t* scores = (bf16_t*)(p.ws + OFF_SCORES);
    const int nF = 32;
    for (int t = blockIdx.x; t < nF * NB; t += gridDim.x) {
        const int ft = t % nF, tok0 = (t / nF) * TPB;
        f32x16 sc[1][2];
        gemm_block<1, 2, 3>(lds, Wt + (size_t)ft * 64 * 1024, 1024, X + (size_t)tok0 * 1024, 1024, 1024, sc);
#pragma unroll
        for (int j = 0; j < 2; ++j) {
            const int tok = tok0 + wt * 64 + j * 32 + r;
            bf16_t* dst = scores + (size_t)tok * 2048 + ft * 64 + wf * 32;
#pragma unroll
            for (int g4 = 0; g4 < 4; ++g4)
                *(u32x2*)(dst + 8 * g4 + 4 * h) = (u32x2){pk2(sc[0][j][4 * g4], sc[0][j][4 * g4 + 1]), pk2(sc[0][j][4 * g4 + 2], sc[0][j][4 * g4 + 3])};
        }
    }
}
DI void phase_peer_pq(const Params& p, LAS uchar* lds, int layer, bool xonly) {
    const pg8::Gemm g{(const bf16_t*)(p.ws + OFF_HBF), (const bf16_t*)(p.ws + OFF_PWQ) + (size_t)layer * 2048 * 1024, NT, 2048, 1024};
    const TileOrder S{8, 8 * NB * 32, true};
    const EpiPQ E{(bf16_t*)(p.ws + OFF_SCORES)};
    pg8::gemm_phase<EpiPQ, TileOrder, true, true>(lds, g, S, E);
    if (!xonly) phase_peer_pq_ctx(p, lds, layer);
}
DI void phase_peer_scores(const Params& p, LAS uchar* lds, int layer, bool xonly) {
    const int tid = threadIdx.x, wave = __builtin_amdgcn_readfirstlane(tid >> 6), lane = tid & 63, r = lane & 31, h = lane >> 5, wf = wave >> 2, wt = wave & 3;
    const bf16_t* PQ = (const bf16_t*)(p.ws + OFF_PQ);
    const bf16_t* keys = (const bf16_t*)(p.ws + OFF_PKEYS) + (size_t)layer * 16 * 128 * 128;
    bf16_t* scores = (bf16_t*)(p.ws + OFF_SCORES);
    const int nF = 16, nT = xonly ? NB * 32 : NT / 256;
    for (int t = blockIdx.x; t < nF * nT; t += gridDim.x) {
        const int ft = t % nF, tt = t / nF;
        const int tok0 = xonly ? (tt / 32) * TPB + LCTX + (tt % 32) * 256 : tt * 256;
        f32x16 sc[2][2];
        gemm_block<2, 2, 2>(lds, keys + (size_t)ft * 128 * 128, 128, PQ + (size_t)tok0 * 2048 + ft * 128, 2048, 128, sc);
#pragma unroll
        for (int j = 0; j < 2; ++j) {
            const int tok = tok0 + wt * 64 + j * 32 + r;
            bf16_t* dst = scores + (size_t)tok * 2048 + ft * 128 + wf * 64;
#pragma unroll
            for (int i = 0; i < 2; ++i)
#pragma unroll
                for (int g4 = 0; g4 < 4; ++g4)
                    *(u32x2*)(dst + i * 32 + 8 * g4 + 4 * h) = (u32x2){pk2(sc[i][j][4 * g4], sc[i][j][4 * g4 + 1]), pk2(sc[i][j][4 * g4 + 2], sc[i][j][4 * g4 + 3])};
        }
    }
}

DI void phase_peer_scores_fused(const Params& p, LAS uchar* lds, int layer, bool xonly) {
    const int tid = threadIdx.x, wave = __builtin_amdgcn_readfirstlane(tid >> 6), lane = tid & 63, r = lane & 31, h = lane >> 5, wf = wave >> 2, wt = wave & 3;
    const bf16_t* Wt = (const bf16_t*)(p.ws + OFF_PWQ) + (size_t)layer * 2048 * 1024;
    const bf16_t* X = (const bf16_t*)(p.ws + OFF_HBF);
    const bf16_t* keys = (const bf16_t*)(p.ws + OFF_PKEYS) + (size_t)layer * 16 * 128 * 128;
    bf16_t* scores = (bf16_t*)(p.ws + OFF_SCORES);
    const int nF = 16, nT = xonly ? NB * 32 : NT / 256;
    for (int t = blockIdx.x; t < nF * nT; t += gridDim.x) {
        const int ft = t % nF, tt = t / nF;
        const int tok0 = xonly ? (tt / 32) * TPB + LCTX + (tt % 32) * 256 : tt * 256;
        f32x16 acc[2][2];
        gemm_block<2, 2, 3>(lds, Wt + (size_t)ft * 128 * 1024, 1024, X + (size_t)tok0 * 1024, 1024, 1024, acc);
        dma_t128(lds + 65536, (const uchar*)(keys + (size_t)ft * 128 * 128), 256, 128, wave, lane);
        dma_t128(lds + 65536 + 16384, (const uchar*)(keys + (size_t)ft * 128 * 128 + 64), 256, 128, wave, lane);
#pragma unroll
        for (int j = 0; j < 2; ++j) {
            const int tl = wt * 64 + j * 32 + r;
#pragma unroll
            for (int i = 0; i < 2; ++i)
#pragma unroll
                for (int g4 = 0; g4 < 4; ++g4) {
                    u32x2 w; w.x = pk2(acc[i][j][4 * g4], acc[i][j][4 * g4 + 1]); w.y = pk2(acc[i][j][4 * g4 + 2], acc[i][j][4 * g4 + 3]);
                    *(LAS u32x2*)(lds + wf * 32768 + t128_off(tl, i * 4 + g4) + 8 * h) = w;
                }
        }
        WAIT_VM0();
        __syncthreads();
        f32x16 sc[2][2];
#pragma unroll
        for (int i = 0; i < 2; ++i)
#pragma unroll
            for (int j = 0; j < 2; ++j)
#pragma unroll
                for (int e = 0; e < 16; ++e) sc[i][j][e] = 0.f;
#pragma unroll
        for (int dh = 0; dh < 2; ++dh)
#pragma unroll
            for (int kk = 0; kk < 4; ++kk) {
                bf16x8 a[2], bq[2];
#pragma unroll
                for (int i = 0; i < 2; ++i) a[i] = ldsfrag(lds + 65536 + dh * 16384, t128_off(wf * 64 + i * 32 + r, 2 * kk + h));
#pragma unroll
                for (int j = 0; j < 2; ++j) bq[j] = ldsfrag(lds + dh * 32768, t128_off(wt * 64 + j * 32 + r, 2 * kk + h));
#pragma unroll
                for (int i = 0; i < 2; ++i)
#pragma unroll
                    for (int j = 0; j < 2; ++j) sc[i][j] = MFMA32(a[i], bq[j], sc[i][j]);
            }
#pragma unroll
        for (int j = 0; j < 2; ++j) {
            const int tok = tok0 + wt * 64 + j * 32 + r;
            bf16_t* dst = scores + (size_t)tok * 2048 + ft * 128 + wf * 64;
#pragma unroll
            for (int i = 0; i < 2; ++i)
#pragma unroll
                for (int g4 = 0; g4 < 4; ++g4)
                    *(u32x2*)(dst + i * 32 + 8 * g4 + 4 * h) = (u32x2){pk2(sc[i][j][4 * g4], sc[i][j][4 * g4 + 1]), pk2(sc[i][j][4 * g4 + 2], sc[i][j][4 * g4 + 3])};
        }
        __syncthreads();
    }
}

DI int fkey(float x) { return __float_as_int(x); }
DI float funkey(int k) { return __int_as_float(k); }
DI int kmax(int a, int b) { int d; asm("v_max_f32 %0, %1, %2" : "=v"(d) : "v"(a), "v"(b)); return d; }
DI int kmin(int a, int b) { int d; asm("v_min_f32 %0, %1, %2" : "=v"(d) : "v"(a), "v"(b)); return d; }
constexpr int KEY_MIN = (int)0xff800000;
DI void ce_desc(int& a, int& b) { const int mx = kmax(a, b), mn = kmin(a, b); a = mx; b = mn; }
DI void sort16_desc(int (&v)[16]) {
#pragma unroll
    for (int k = 2; k <= 16; k <<= 1)
#pragma unroll
        for (int j = k >> 1; j > 0; j >>= 1)
#pragma unroll
            for (int i = 0; i < 16; ++i) {
                const int l = i ^ j;
                if (l > i) { if ((i & k) == 0) ce_desc(v[i], v[l]); else ce_desc(v[l], v[i]); }
            }
}
DI void merge16_desc(int (&top)[16], const int (&v)[16]) {
#pragma unroll
    for (int i = 0; i < 16; ++i) top[i] = kmax(top[i], v[15 - i]);
#pragma unroll
    for (int j = 8; j > 0; j >>= 1)
#pragma unroll
        for (int i = 0; i < 16; ++i) {
            const int l = i ^ j;
            if (l > i) ce_desc(top[i], top[l]);
        }
}
DI void phase_peer_topk(const Params& p, LAS uchar* lds, bool xonly) {
    const int tid = threadIdx.x, wave = __builtin_amdgcn_readfirstlane(tid >> 6), lane = tid & 63;
    LAS uchar* wl = lds + wave * 9216;
    const bf16_t* scores = (const bf16_t*)(p.ws + OFF_SCORES);
    const int ngroups = (xonly ? NB * SEQ : NT) / 4;
    for (int gi = blockIdx.x * NW + wave; gi < ngroups; gi += gridDim.x * NW) {
        const int rix0 = gi * 4;
        const int tok0 = xonly ? (rix0 / SEQ) * TPB + LCTX + (rix0 % SEQ) : rix0;
        int tk[16];
#pragma unroll
        for (int i = 0; i < 16; ++i) tk[i] = KEY_MIN;
        for (int chunk = 0; chunk < 2; ++chunk) {
            u32x4 ld[8];
#pragma unroll
            for (int q = 0; q < 8; ++q) {
                const int rr = q * 8 + (lane >> 3);
                ld[q] = *(const u32x4*)(scores + (size_t)(tok0 + (rr >> 4)) * 2048 + (rr & 15) * 128 + chunk * 64 + (lane & 7) * 8);
            }
#pragma unroll
            for (int q = 0; q < 8; ++q) *(LAS u32x4*)(wl + (q * 8 + (lane >> 3)) * 144 + (lane & 7) * 16) = ld[q];
#pragma unroll
            for (int q2 = 0; q2 < 4; ++q2) {
                int blk[16];
#pragma unroll
                for (int qq = 0; qq < 2; ++qq) {
                    const int q = 2 * q2 + qq;
                    const u32x4 v = *(const LAS u32x4*)(wl + lane * 144 + q * 16);
                    const float vv[8] = {bflo(v.x), bfhi(v.x), bflo(v.y), bfhi(v.y), bflo(v.z), bfhi(v.z), bflo(v.w), bfhi(v.w)};
#pragma unroll
                    for (int e = 0; e < 8; ++e) blk[8 * qq + e] = (fkey(vv[e]) & ~127) | (chunk * 64 + q * 8 + e);
                }
                sort16_desc(blk);
                merge16_desc(tk, blk);
            }
        }
        float av[16], bv[16];
#pragma unroll
        for (int i = 0; i < 16; ++i) {
            const int pk = __builtin_amdgcn_update_dpp(0, tk[i], 0xB1, 0xF, 0xF, false);
            av[i] = funkey(tk[i] & ~127); bv[i] = funkey(pk & ~127);
            *(LAS int*)(wl + lane * 144 + i * 4) = tk[i] & 127;
            *(LAS int*)(wl + lane * 144 + 64 + i * 4) = pk & 127;
        }
        int ck[16];
#pragma unroll
        for (int i = 0; i < 16; ++i) ck[i] = KEY_MIN;
        {
            int blk[16];
            blk[0] = (fkey(av[0] + bv[0]) & ~255) | 0;
            blk[1] = (fkey(av[0] + bv[1]) & ~255) | 1;
            blk[2] = (fkey(av[0] + bv[2]) & ~255) | 2;
            blk[3] = (fkey(av[0] + bv[3]) & ~255) | 3;
            blk[4] = (fkey(av[0] + bv[4]) & ~255) | 4;
            blk[5] = (fkey(av[0] + bv[5]) & ~255) | 5;
            blk[6] = (fkey(av[0] + bv[6]) & ~255) | 6;
            blk[7] = (fkey(av[0] + bv[7]) & ~255) | 7;
            blk[8] = (fkey(av[0] + bv[8]) & ~255) | 8;
            blk[9] = (fkey(av[0] + bv[9]) & ~255) | 9;
            blk[10] = (fkey(av[0] + bv[10]) & ~255) | 10;
            blk[11] = (fkey(av[0] + bv[11]) & ~255) | 11;
            blk[12] = (fkey(av[0] + bv[12]) & ~255) | 12;
            blk[13] = (fkey(av[0] + bv[13]) & ~255) | 13;
            blk[14] = (fkey(av[0] + bv[14]) & ~255) | 14;
            blk[15] = (fkey(av[0] + bv[15]) & ~255) | 15;
            sort16_desc(blk);
            merge16_desc(ck, blk);
        }
        {
            int blk[16];
            blk[0] = (fkey(av[1] + bv[0]) & ~255) | 16;
            blk[1] = (fkey(av[1] + bv[1]) & ~255) | 17;
            blk[2] = (fkey(av[1] + bv[2]) & ~255) | 18;
            blk[3] = (fkey(av[1] + bv[3]) & ~255) | 19;
            blk[4] = (fkey(av[1] + bv[4]) & ~255) | 20;
            blk[5] = (fkey(av[1] + bv[5]) & ~255) | 21;
            blk[6] = (fkey(av[1] + bv[6]) & ~255) | 22;
            blk[7] = (fkey(av[1] + bv[7]) & ~255) | 23;
            blk[8] = (fkey(av[2] + bv[0]) & ~255) | 32;
            blk[9] = (fkey(av[2] + bv[1]) & ~255) | 33;
            blk[10] = (fkey(av[2] + bv[2]) & ~255) | 34;
            blk[11] = (fkey(av[2] + bv[3]) & ~255) | 35;
            blk[12] = (fkey(av[2] + bv[4]) & ~255) | 36;
            blk[13] = (fkey(av[3] + bv[0]) & ~255) | 48;
            blk[14] = (fkey(av[3] + bv[1]) & ~255) | 49;
            blk[15] = (fkey(av[3] + bv[2]) & ~255) | 50;
            sort16_desc(blk);
            merge16_desc(ck, blk);
        }
        {
            int blk[16];
            blk[0] = (fkey(av[3] + bv[3]) & ~255) | 51;
            blk[1] = (fkey(av[4] + bv[0]) & ~255) | 64;
            blk[2] = (fkey(av[4] + bv[1]) & ~255) | 65;
            blk[3] = (fkey(av[4] + bv[2]) & ~255) | 66;
            blk[4] = (fkey(av[5] + bv[0]) & ~255) | 80;
            blk[5] = (fkey(av[5] + bv[1]) & ~255) | 81;
            blk[6] = (fkey(av[6] + bv[0]) & ~255) | 96;
            blk[7] = (fkey(av[6] + bv[1]) & ~255) | 97;
            blk[8] = (fkey(av[7] + bv[0]) & ~255) | 112;
            blk[9] = (fkey(av[7] + bv[1]) & ~255) | 113;
            blk[10] = (fkey(av[8] + bv[0]) & ~255) | 128;
            blk[11] = (fkey(av[9] + bv[0]) & ~255) | 144;
            blk[12] = (fkey(av[10] + bv[0]) & ~255) | 160;
            blk[13] = (fkey(av[11] + bv[0]) & ~255) | 176;
            blk[14] = (fkey(av[12] + bv[0]) & ~255) | 192;
            blk[15] = (fkey(av[13] + bv[0]) & ~255) | 208;
            sort16_desc(blk);
            merge16_desc(ck, blk);
        }
        {
            int blk[16];
            blk[0] = (fkey(av[14] + bv[0]) & ~255) | 224;
            blk[1] = (fkey(av[15] + bv[0]) & ~255) | 240;
            blk[2] = KEY_MIN;
            blk[3] = KEY_MIN;
            blk[4] = KEY_MIN;
            blk[5] = KEY_MIN;
            blk[6] = KEY_MIN;
            blk[7] = KEY_MIN;
            blk[8] = KEY_MIN;
            blk[9] = KEY_MIN;
            blk[10] = KEY_MIN;
            blk[11] = KEY_MIN;
            blk[12] = KEY_MIN;
            blk[13] = KEY_MIN;
            blk[14] = KEY_MIN;
            blk[15] = KEY_MIN;
            sort16_desc(blk);
            merge16_desc(ck, blk);
        }
        float cv[16]; int cp[16];
#pragma unroll
        for (int k = 0; k < 16; ++k) {
            const int pos = ck[k] & 255;
            const int n1 = *(const LAS int*)(wl + lane * 144 + (pos >> 4) * 4), n2 = *(const LAS int*)(wl + lane * 144 + 64 + (pos & 15) * 4);
            cp[k] = n1 * 128 + n2;
            cv[k] = funkey(ck[k] & ~255);
        }
        float ge[16]; float gs = 0.f;
#pragma unroll
        for (int k = 0; k < 16; ++k) { ge[k] = __expf(cv[k] - cv[0]); gs += ge[k]; }
        const float ginv = 1.0f / gs;
        if ((lane & 1) == 0) {
            const int tok = tok0 + (lane >> 4), hd = (lane >> 1) & 7;
            unsigned short* ep = (unsigned short*)(p.ws + OFF_EIDX) + (size_t)tok * 128 + hd * 16;
            float* gp = (float*)(p.ws + OFF_GATE) + (size_t)tok * 128 + hd * 16;
            *(u32x4*)(ep) = (u32x4){(unsigned)cp[0] | ((unsigned)cp[1] << 16), (unsigned)cp[2] | ((unsigned)cp[3] << 16), (unsigned)cp[4] | ((unsigned)cp[5] << 16), (unsigned)cp[6] | ((unsigned)cp[7] << 16)};
            *(u32x4*)(ep + 8) = (u32x4){(unsigned)cp[8] | ((unsigned)cp[9] << 16), (unsigned)cp[10] | ((unsigned)cp[11] << 16), (unsigned)cp[12] | ((unsigned)cp[13] << 16), (unsigned)cp[14] | ((unsigned)cp[15] << 16)};
#pragma unroll
            for (int q = 0; q < 4; ++q) *(f32x4*)(gp + 4 * q) = (f32x4){ge[4 * q] * ginv, ge[4 * q + 1] * ginv, ge[4 * q + 2] * ginv, ge[4 * q + 3] * ginv};
        }
    }
}

DI float gelu_f(float v) {
    const float t = __builtin_amdgcn_rcpf(fabsf(v) * 0.2316418882f + 1.0f);
    float q = t * 0.5307027145f + (-0.7265760135f); q = q * t + 0.7107068705f; q = q * t + (-0.142248368f); q = q * t + 0.127414796f; q = q * t;
    const float m = v * (q * __builtin_amdgcn_exp2f((v * v) * (-0.72134752044f)));
    return v < 0.f ? m : v - m;
}
DI void phase_peer_gather(const Params& p, int layer, bool xonly, bool last, bool dry = false) {
    const int tid = threadIdx.x, wave = __builtin_amdgcn_readfirstlane(tid >> 6), lane = tid & 63;
    const uchar* PU = p.ws + OFF_PU + (size_t)layer * 16384 * 512;
    const uchar* PV = p.ws + OFF_PV + (size_t)layer * 16384 * 512;
    const float* mod = (const float*)(p.ws + OFF_MOD);
    const int nrows = xonly ? NB * SEQ : NT;
    const int qq = lane >> 4, c16 = lane & 15;
    for (int rix = blockIdx.x * NW + wave; rix < nrows; rix += gridDim.x * NW) {
        const int tok = xonly ? (rix / SEQ) * TPB + LCTX + (rix % SEQ) : rix;
        const int mid = mod_id(tok);
        i32x8 hb[8];
        {
            const uchar* h8 = p.ws + OFF_H8 + (size_t)tok * DM + qq * 16;
#pragma unroll
            for (int kb = 0; kb < 8; ++kb) {
                const u32x4 lo = *(const u32x4*)(h8 + kb * 128), hi = *(const u32x4*)(h8 + kb * 128 + 64);
                hb[kb] = (i32x8){(int)lo.x, (int)lo.y, (int)lo.z, (int)lo.w, (int)hi.x, (int)hi.y, (int)hi.z, (int)hi.w};
            }
        }
        const unsigned eip = ((const unsigned*)((const unsigned short*)(p.ws + OFF_EIDX) + (size_t)tok * 128))[lane];
        const f32x2 gtp = ((const f32x2*)((const float*)(p.ws + OFF_GATE) + (size_t)tok * 128))[lane];
        f32x2 out2[8];
#pragma unroll
        for (int e = 0; e < 8; ++e) out2[e] = (f32x2){0.f, 0.f};
        for (int hd = 0; hd < 8; ++hd) {
            u32x4 ua[8];
            {
                const unsigned prl = (unsigned)__shfl((int)eip, hd * 8 + (c16 >> 1));
                const unsigned exl = (c16 & 1) ? (prl >> 16) : (prl & 0xffffu);
                const uchar* urow = PU + (size_t)exl * 512 + qq * 16;
#pragma unroll
                for (int kb = 0; kb < 8; ++kb) ua[kb] = *(const u32x4*)(urow + kb * 64);
            }
            int ex[16]; u32x2 ub[16];
#pragma unroll
            for (int k = 0; k < 16; ++k) {
                const unsigned pr = (unsigned)__builtin_amdgcn_readlane((int)eip, hd * 8 + (k >> 1));
                ex[k] = (k & 1) ? (int)(pr >> 16) : (int)(pr & 0xffffu);
                ub[k] = *(const u32x2*)(PV + (size_t)ex[k] * 512 + 8 * lane);
            }
            f32x4 za = (f32x4){0.f, 0.f, 0.f, 0.f}, zb = za;
#pragma unroll
            for (int kb = 0; kb < 8; kb += 2) {
                za = __builtin_amdgcn_mfma_scale_f32_16x16x128_f8f6f4((i32x8){(int)ua[kb].x, (int)ua[kb].y, (int)ua[kb].z, (int)ua[kb].w, 0, 0, 0, 0}, hb[kb], za, 4, 0, 0, 0x7f7f7f7f, 0, 0x7f7f7f7f);
                zb = __builtin_amdgcn_mfma_scale_f32_16x16x128_f8f6f4((i32x8){(int)ua[kb + 1].x, (int)ua[kb + 1].y, (int)ua[kb + 1].z, (int)ua[kb + 1].w, 0, 0, 0, 0}, hb[kb + 1], zb, 4, 0, 0, 0x7f7f7f7f, 0, 0x7f7f7f7f);
            }
            za += zb;
            const int e4 = lane & 3, kl = 4 * qq + e4;
            const float zl = e4 == 0 ? za[0] : e4 == 1 ? za[1] : e4 == 2 ? za[2] : za[3];
            const float g0 = __shfl(gtp.x, hd * 8 + (kl >> 1)), g1 = __shfl(gtp.y, hd * 8 + (kl >> 1));
            const float zz = zl * (1.0f / 64.0f);
            const float a = gelu_f(zz) * ((kl & 1) ? g1 : g0);
#pragma unroll
            for (int k = 0; k < 16; ++k) {
                const float ak = __int_as_float(__builtin_amdgcn_readlane(__float_as_int(a), 16 * (k >> 2) + (k & 3)));
#pragma unroll
                for (int q = 0; q < 2; ++q) {
                    const f32x2 ak2 = (f32x2){ak, ak};
                    out2[4 * q] += ak2 * __builtin_amdgcn_cvt_scalef32_pk_f32_fp4(ub[k][q], 1.0f, 0);
                    out2[4 * q + 1] += ak2 * __builtin_amdgcn_cvt_scalef32_pk_f32_fp4(ub[k][q], 1.0f, 1);
                    out2[4 * q + 2] += ak2 * __builtin_amdgcn_cvt_scalef32_pk_f32_fp4(ub[k][q], 1.0f, 2);
                    out2[4 * q + 3] += ak2 * __builtin_amdgcn_cvt_scalef32_pk_f32_fp4(ub[k][q], 1.0f, 3);
                }
            }
        }
        float* rrow = res_row(p, tok) + 16 * lane;
        const float* mm = mod + (size_t)(layer * 3 + mid) * 6144;
        float xn[16]; float ss = 0.f;
#pragma unroll
        for (int q = 0; q < 4; ++q) {
            const f32x4 g = *(const f32x4*)(mm + 5 * 1024 + 16 * lane + 4 * q), x0 = *(const f32x4*)(rrow + 4 * q);
            f32x4 o;
#pragma unroll
            for (int e = 0; e < 4; ++e) { o[e] = x0[e] + g[e] * (0.5f * out2[2 * q + (e >> 1)][e & 1]); xn[4 * q + e] = o[e]; ss += o[e] * o[e]; }
            if (!dry) *(f32x4*)(rrow + 4 * q) = o;
        }
        if (dry) { if (ss == 123.456f) rrow[0] = ss; continue; }
        if (!last) {
            ss = wave_sum(ss);
            const float rstd = rsqrtf(ss * (1.0f / 1024.0f) + EPS);
            const float* mn = mod + (size_t)((layer + 1) * 3 + mid) * 6144 + 16 * lane;
            const float* gn = p.norm1 + (layer + 1) * DM + 16 * lane;
            bf16_t* hdst = (bf16_t*)(p.ws + OFF_HBF) + (size_t)tok * DM + 16 * lane;
            float y[16];
#pragma unroll
            for (int e = 0; e < 16; ++e) y[e] = xn[e] * rstd * gn[e] * (1.0f + mn[1024 + e]) + mn[e];
            *(u32x4*)(hdst) = (u32x4){pk2(y[0], y[1]), pk2(y[2], y[3]), pk2(y[4], y[5]), pk2(y[6], y[7])};
            *(u32x4*)(hdst + 8) = (u32x4){pk2(y[8], y[9]), pk2(y[10], y[11]), pk2(y[12], y[13]), pk2(y[14], y[15])};
        }
    }
}

struct EpiInOdd {
    static constexpr bool PERM = true, AFTER_DRAIN = false;
    const Params* pp;
    DI void operator()(const f32x4 (&acc)[2][2][4][2], const pg8::Unit& u, int wr, int wc, int fr, int fq) const {
        const Params& p = *pp;
        bf16_t* proj1 = (bf16_t*)(p.ws + OFF_PROJ1);
        float* ssq64 = (float*)(p.ws + OFF_SSQ64);
        const int fw = u.pn * 256 + wc * 64;
#pragma unroll
        for (int ai = 0; ai < 2; ++ai)
#pragma unroll
            for (int m = 0; m < 4; ++m) {
                const int tok = u.pm * 256 + ai * 128 + wr * 64 + m * 16 + fr;
                bf16_t* dst = proj1 + (size_t)tok * 2048 + fw + 8 * fq;
                float ss = 0.f;
#pragma unroll
                for (int bj = 0; bj < 2; ++bj) {
                    const f32x4 v0 = acc[ai][bj][m][0], v1 = acc[ai][bj][m][1];
                    ss += v0[0] * v0[0] + v0[1] * v0[1] + v0[2] * v0[2] + v0[3] * v0[3] + v1[0] * v1[0] + v1[1] * v1[1] + v1[2] * v1[2] + v1[3] * v1[3];
                    *(u32x4*)(dst + 32 * bj) = (u32x4){pk2(v0[0], v0[1]), pk2(v0[2], v0[3]), pk2(v1[0], v1[1]), pk2(v1[2], v1[3])};
                }
                if (fw < 384) {
                    ss += __shfl_xor(ss, 16); ss += __shfl_xor(ss, 32);
                    if (fq == 0) ssq64[(size_t)tok * 8 + (fw >> 6)] = ss;
                }
            }
    }
};
DI void phase_inproj_odd_ctx(const Params& p, LAS uchar* lds) {
    const int tid = threadIdx.x, wave = __builtin_amdgcn_readfirstlane(tid >> 6), lane = tid & 63, r = lane & 31, h = lane >> 5, wf = wave >> 2, wt = wave & 3;
    const bf16_t* Wt = (const bf16_t*)(p.ws + OFF_WINO);
    const bf16_t* X = (const bf16_t*)(p.ws + OFF_HBF);
    bf16_t* proj1 = (bf16_t*)(p.ws + OFF_PROJ1);
    float* ssq64 = (float*)(p.ws + OFF_SSQ64);
    const int nF = 32;
    for (int t = blockIdx.x; t < nF * NB; t += gridDim.x) {
        const int ft = t % nF, tok0 = (t / nF) * TPB;
        f32x16 acc[1][2];
        gemm_block<1, 2, 3>(lds, Wt + (size_t)ft * 64 * 1024, 1024, X + (size_t)tok0 * 1024, 1024, 1024, acc);
        const int qa = 2 * ft + wf, q = qa & 7, fw = 256 * (qa >> 3) + 64 * (q & 3), col0 = fw + 32 * (q >> 2);
#pragma unroll
        for (int j = 0; j < 2; ++j) {
            const int tok = tok0 + wt * 64 + j * 32 + r;
            bf16_t* dst = proj1 + (size_t)tok * 2048 + col0;
            float ss = 0.f;
#pragma unroll
            for (int g4 = 0; g4 < 4; ++g4) {
                const float a0 = acc[0][j][4 * g4], a1 = acc[0][j][4 * g4 + 1], a2 = acc[0][j][4 * g4 + 2], a3 = acc[0][j][4 * g4 + 3];
                ss += a0 * a0 + a1 * a1 + a2 * a2 + a3 * a3;
                *(u32x2*)(dst + 8 * g4 + 4 * h) = (u32x2){pk2(a0, a1), pk2(a2, a3)};
            }
            if (fw < 384) {
                ss += __shfl_xor(ss, 32);
                if (h == 0) atomicAdd(&ssq64[(size_t)tok * 8 + (fw >> 6)], ss);
            }
        }
    }
}
DI void phase_inproj_odd(const Params& p, LAS uchar* lds) {
    const pg8::Gemm g{(const bf16_t*)(p.ws + OFF_HBF), (const bf16_t*)(p.ws + OFF_WINO), NT, 2048, 1024};
    const TileOrder S{8, 8 * NB * 32, true};
    const EpiInOdd E{&p};
    pg8::gemm_phase<EpiInOdd, TileOrder, true, true>(lds, g, S, E);
    phase_inproj_odd_ctx(p, lds);
}

constexpr int G_GS = 0, G_GSLD = 65;
DI void gla_gates(const Params& p, LAS uchar* lds, int tok0, int hh, int dir, int gin_off) {
    const int tid = threadIdx.x & 255, k = tid & 63, cgp = tid >> 6;
    LAS float* Gs = (LAS float*)(lds + G_GS);
    const float* wg = dir ? p.d_wg_b : p.d_wg_f;
    const float* bg = dir ? p.d_bg_b : p.d_bg_f;
    const bf16_t* proj1 = (const bf16_t*)(p.ws + OFF_PROJ1);
    if (tid < 128) {
        const int row = tid >> 1, hf = tid & 1;
        *(LAS u32x4*)(lds + gin_off + row * 32 + hf * 16) = *(const u32x4*)(proj1 + (size_t)(tok0 + row) * 2048 + (dir ? 1968 : 1952) + hf * 8);
    }
    float w[16];
#pragma unroll
    for (int rr = 0; rr < 16; ++rr) w[rr] = wg[rr * 256 + hh * 64 + k];
    const float bias = bg[hh * 64 + k];
    __syncthreads();
#pragma unroll 4
    for (int cc = 0; cc < 16; ++cc) {
        const int c = cgp * 16 + cc;
        const u32x4 g0 = *(const LAS u32x4*)(lds + gin_off + c * 32), g1 = *(const LAS u32x4*)(lds + gin_off + c * 32 + 16);
        float z = bias;
        z += w[0] * bflo(g0.x) + w[1] * bfhi(g0.x) + w[2] * bflo(g0.y) + w[3] * bfhi(g0.y) + w[4] * bflo(g0.z) + w[5] * bfhi(g0.z) + w[6] * bflo(g0.w) + w[7] * bfhi(g0.w);
        z += w[8] * bflo(g1.x) + w[9] * bfhi(g1.x) + w[10] * bflo(g1.y) + w[11] * bfhi(g1.y) + w[12] * bflo(g1.z) + w[13] * bfhi(g1.z) + w[14] * bflo(g1.w) + w[15] * bfhi(g1.w);
        const float ls = fminf(z, 0.f) - __logf(1.0f + __expf(-fabsf(z)));
        Gs[c * G_GSLD + k] = ls * (1.0f / 16.0f);
    }
}
DI float gla_cumsum(LAS uchar* lds, int dir, int tot_off) {
    const int tid = threadIdx.x & 255, k = tid & 63, blk = tid >> 6;
    LAS float* Gs = (LAS float*)(lds + G_GS);
    LAS float* tot = (LAS float*)(lds + tot_off);
    float v[16];
#pragma unroll
    for (int i = 0; i < 16; ++i) v[i] = Gs[(blk * 16 + i) * G_GSLD + k];
    if (dir == 0) {
#pragma unroll
        for (int i = 1; i < 16; ++i) v[i] += v[i - 1];
    } else {
#pragma unroll
        for (int i = 14; i >= 0; --i) v[i] += v[i + 1];
    }
    tot[blk * 64 + k] = dir == 0 ? v[15] : v[0];
    __syncthreads();
    const float t0 = tot[k], t1 = tot[64 + k], t2 = tot[128 + k], t3 = tot[192 + k];
    float off;
    if (dir == 0) off = (blk > 0 ? t0 : 0.f) + (blk > 1 ? t1 : 0.f) + (blk > 2 ? t2 : 0.f);
    else off = (blk < 3 ? t3 : 0.f) + (blk < 2 ? t2 : 0.f) + (blk < 1 ? t1 : 0.f);
#pragma unroll
    for (int i = 0; i < 16; ++i) Gs[(blk * 16 + i) * G_GSLD + k] = v[i] + off;
    return (t0 + t1) + (t2 + t3);
}
DI void gla_build_vt(const Params& p, LAS uchar* vt, int tok0, int hh) {
    const int tid = threadIdx.x & 255, c = tid & 63, vg = tid >> 6;
    const bf16_t* proj1 = (const bf16_t*)(p.ws + OFF_PROJ1);
    const u32x4* sp = (const u32x4*)(proj1 + (size_t)(tok0 + c) * 2048 + 896 + hh * 128 + vg * 32);
#pragma unroll
    for (int q = 0; q < 4; ++q) {
        const u32x4 w = sp[q];
        const unsigned ww[4] = {w.x, w.y, w.z, w.w};
#pragma unroll
        for (int e = 0; e < 4; ++e) {
            const int v = vg * 32 + q * 8 + 2 * e;
            *(LAS bf16_t*)(vt + t128_off(v, c >> 3) + (c & 7) * 2) = (bf16_t)(ww[e] & 0xffffu);
            *(LAS bf16_t*)(vt + t128_off(v + 1, c >> 3) + (c & 7) * 2) = (bf16_t)(ww[e] >> 16);
        }
    }
}

DI void gla_g1_unit(const Params& p, LAS uchar* lds, int u) {
    constexpr int O_KST = 16896, O_VT = 25088, O_BL = 41472;
    const int tid = threadIdx.x & 255, wave = __builtin_amdgcn_readfirstlane(tid >> 6), lane = tid & 63, r = lane & 31, h = lane >> 5;
    const int dir = u / 1056, rem = u % 1056, b = rem / 528, hh = (rem / 132) % 4, n = rem % 132;
    const int tok0 = b * TPB + 64 * n;
    const bf16_t* proj1 = (const bf16_t*)(p.ws + OFF_PROJ1);
    LAS float* Gs = (LAS float*)(lds + G_GS);
    LAS float* bl = (LAS float*)(lds + O_BL);
    gla_gates(p, lds, tok0, hh, dir, 43008);
    __syncthreads();
    {
        const float tot = gla_cumsum(lds, dir, O_BL + 256);
        if (tid < 64) { bl[tid] = tot; ((float*)(p.ws + OFF_GDEC))[(size_t)u * 64 + tid] = __expf(tot); }
    }
    __syncthreads();
    {
        const int c = tid & 63, kg = tid >> 6;
        const u32x4* kp = (const u32x4*)(proj1 + (size_t)(tok0 + c) * 2048 + 640 + hh * 64 + kg * 16);
#pragma unroll
        for (int q = 0; q < 2; ++q) {
            const u32x4 w = kp[q];
            const unsigned ww[4] = {w.x, w.y, w.z, w.w};
#pragma unroll
            for (int e = 0; e < 4; ++e) {
                const int k = kg * 16 + q * 8 + 2 * e;
                const float v0 = bflo(ww[e]) * __expf(bl[k] - Gs[c * G_GSLD + k]);
                const float v1 = bfhi(ww[e]) * __expf(bl[k + 1] - Gs[c * G_GSLD + k + 1]);
                *(LAS bf16_t*)(lds + O_KST + t128_off(k, c >> 3) + (c & 7) * 2) = f2bf(v0);
                *(LAS bf16_t*)(lds + O_KST + t128_off(k + 1, c >> 3) + (c & 7) * 2) = f2bf(v1);
            }
        }
        gla_build_vt(p, lds + O_VT, tok0, hh);
    }
    __syncthreads();
    f32x16 acc[2];
#pragma unroll
    for (int j = 0; j < 2; ++j)
#pragma unroll
        for (int e = 0; e < 16; ++e) acc[j][e] = 0.f;
#pragma unroll
    for (int kk = 0; kk < 4; ++kk) {
        const bf16x8 a = ldsfrag(lds + O_VT, t128_off(wave * 32 + r, 2 * kk + h));
#pragma unroll
        for (int j = 0; j < 2; ++j) acc[j] = MFMA32(a, ldsfrag(lds + O_KST, t128_off(j * 32 + r, 2 * kk + h)), acc[j]);
    }
    float* ds = (float*)(p.ws + OFF_GDS) + (size_t)u * 8192;
#pragma unroll
    for (int j = 0; j < 2; ++j)
#pragma unroll
        for (int e = 0; e < 16; ++e) ds[(wave * 32 + crow(e, h)) * 64 + j * 32 + r] = acc[j][e];
}

DI void gla_scan_task(const Params& p, int bt) {
    const int tid = threadIdx.x;
    const int chain = bt / 16, e = (bt % 16) * NTHR + tid, dir = chain / 8;
    float* ds = (float*)(p.ws + OFF_GDS);
    const float* dec = (const float*)(p.ws + OFF_GDEC);
    float S = 0.f;
    for (int base = 0; base < NCHUNK; base += 12) {
        float d[12], t[12]; size_t off[12];
#pragma unroll
        for (int j = 0; j < 12; ++j) {
            const int step = base + j;
            const int n = dir == 0 ? step : (step < 4 ? 3 - step : 135 - step);
            const size_t u = (size_t)chain * NCHUNK + n;
            off[j] = u * 8192 + e;
            d[j] = dec[u * 64 + (e & 63)];
            t[j] = ds[off[j]];
        }
#pragma unroll
        for (int j = 0; j < 12; ++j) { ds[off[j]] = S; S = d[j] * S + t[j]; }
    }
}

DI void gla_g3_unit(const Params& p, LAS uchar* lds, int v) {
    constexpr int O_AM = 0, O_QT = 16896, O_KIN = 25088, O_VT = 33280, O_ST = 49664, O_SSQ = 66304;
    const int tid = threadIdx.x & 255, wave = __builtin_amdgcn_readfirstlane(tid >> 6), lane = tid & 63, r = lane & 31, h = lane >> 5;
    const int b = v / 512, hh = (v / 128) % 4, n = 4 + (v % 128);
    const int tok0 = b * TPB + 64 * n;
    const bf16_t* proj1 = (const bf16_t*)(p.ws + OFF_PROJ1);
    LAS float* Gs = (LAS float*)(lds + G_GS);
    f32x16 O[2];
#pragma unroll
    for (int j = 0; j < 2; ++j)
#pragma unroll
        for (int e = 0; e < 16; ++e) O[j][e] = 0.f;
    gla_build_vt(p, lds + O_VT, tok0, hh);
    for (int dir = 0; dir < 2; ++dir) {
        const int u = ((dir * 2 + b) * 4 + hh) * 132 + n;
        gla_gates(p, lds, tok0, hh, dir, 67328);
        __syncthreads();
        (void)gla_cumsum(lds, dir, O_SSQ);
        __syncthreads();
        {
            const int c = tid & 63, kg = tid >> 6;
            const u32x4* qp = (const u32x4*)(proj1 + (size_t)(tok0 + c) * 2048 + 384 + hh * 64 + kg * 16);
            const u32x4* kp = (const u32x4*)(proj1 + (size_t)(tok0 + c) * 2048 + 640 + hh * 64 + kg * 16);
#pragma unroll
            for (int q = 0; q < 2; ++q) {
                const u32x4 wq = qp[q], wk = kp[q];
                const unsigned qq[4] = {wq.x, wq.y, wq.z, wq.w}, kk4[4] = {wk.x, wk.y, wk.z, wk.w};
                unsigned oq[4], ok[4];
#pragma unroll
                for (int e = 0; e < 4; ++e) {
                    const int k = kg * 16 + q * 8 + 2 * e;
                    const float b0 = Gs[c * G_GSLD + k], b1 = Gs[c * G_GSLD + k + 1];
                    oq[e] = pk2(bflo(qq[e]) * 0.125f * __expf(b0), bfhi(qq[e]) * 0.125f * __expf(b1));
                    ok[e] = pk2(bflo(kk4[e]) * __expf(-b0), bfhi(kk4[e]) * __expf(-b1));
                }
                *(LAS u32x4*)(lds + O_QT + t128_off(c, kg * 2 + q)) = (u32x4){oq[0], oq[1], oq[2], oq[3]};
                *(LAS u32x4*)(lds + O_KIN + t128_off(c, kg * 2 + q)) = (u32x4){ok[0], ok[1], ok[2], ok[3]};
            }
            const int sv = tid >> 1, kh = tid & 1;
            const f32x4* sp = (const f32x4*)((const float*)(p.ws + OFF_GDS) + (size_t)u * 8192 + sv * 64 + kh * 32);
#pragma unroll
            for (int q = 0; q < 4; ++q) {
                const f32x4 a = sp[2 * q], bq = sp[2 * q + 1];
                *(LAS u32x4*)(lds + O_ST + t128_off(sv, kh * 4 + q)) = (u32x4){pk2(a[0], a[1]), pk2(a[2], a[3]), pk2(bq[0], bq[1]), pk2(bq[2], bq[3])};
            }
        }
        __syncthreads();
        {
            const int st = wave >> 1, ct = wave & 1;
            f32x16 A;
#pragma unroll
            for (int e = 0; e < 16; ++e) A[e] = 0.f;
#pragma unroll
            for (int kk = 0; kk < 4; ++kk) A = MFMA32(ldsfrag(lds + O_KIN, t128_off(st * 32 + r, 2 * kk + h)), ldsfrag(lds + O_QT, t128_off(ct * 32 + r, 2 * kk + h)), A);
            const int c = ct * 32 + r;
#pragma unroll
            for (int g4 = 0; g4 < 4; ++g4) {
                float a4[4];
#pragma unroll
                for (int e = 0; e < 4; ++e) {
                    const int s = st * 32 + 8 * g4 + 4 * h + e;
                    const bool keep = dir == 0 ? (s <= c) : (s >= c);
                    a4[e] = keep ? A[4 * g4 + e] : 0.f;
                }
                *(LAS u32x2*)(lds + O_AM + t128_off(c, st * 4 + g4) + 8 * h) = (u32x2){pk2(a4[0], a4[1]), pk2(a4[2], a4[3])};
            }
        }
        __syncthreads();
#pragma unroll
        for (int kk = 0; kk < 4; ++kk) {
            const bf16x8 av = ldsfrag(lds + O_VT, t128_off(wave * 32 + r, 2 * kk + h));
            const bf16x8 as = ldsfrag(lds + O_ST, t128_off(wave * 32 + r, 2 * kk + h));
#pragma unroll
            for (int j = 0; j < 2; ++j) {
                O[j] = MFMA32(av, ldsfrag(lds + O_AM, t128_off(j * 32 + r, 2 * kk + h)), O[j]);
                O[j] = MFMA32(as, ldsfrag(lds + O_QT, t128_off(j * 32 + r, 2 * kk + h)), O[j]);
            }
        }
        __syncthreads();
    }
    LAS float* ssqp = (LAS float*)(lds + O_SSQ);
#pragma unroll
    for (int j = 0; j < 2; ++j) {
        float ss = 0.f;
#pragma unroll
        for (int e = 0; e < 16; ++e) ss += O[j][e] * O[j][e];
        ss += __shfl_xor(ss, 32);
        if (h == 0) ssqp[wave * 64 + j * 32 + r] = ss;
    }
    __syncthreads();
    bf16_t* aout = (bf16_t*)(p.ws + OFF_AOUT);
#pragma unroll
    for (int j = 0; j < 2; ++j) {
        const int c = j * 32 + r, tok = tok0 + c;
        const float tot = ssqp[c] + ssqp[64 + c] + ssqp[128 + c] + ssqp[192 + c];
        const float rstd = rsqrtf(tot * (1.0f / 128.0f) + EPS);
#pragma unroll
        for (int g4 = 0; g4 < 4; ++g4) {
            const int v0 = wave * 32 + 8 * g4 + 4 * h;
            const f32x4 gn = *(const f32x4*)(p.d_gn + v0);
            const u32x2 rw = *(const u32x2*)(proj1 + (size_t)tok * 2048 + 1408 + hh * 128 + v0);
            const float y0 = O[j][4 * g4] * rstd * gn[0] * silu_f(bflo(rw.x)), y1 = O[j][4 * g4 + 1] * rstd * gn[1] * silu_f(bfhi(rw.x));
            const float y2 = O[j][4 * g4 + 2] * rstd * gn[2] * silu_f(bflo(rw.y)), y3 = O[j][4 * g4 + 3] * rstd * gn[3] * silu_f(bfhi(rw.y));
            *(u32x2*)(aout + (size_t)tok * DM + 512 + hh * 128 + v0) = (u32x2){pk2(y0, y1), pk2(y2, y3)};
        }
    }
    __syncthreads();
}

DI void phase_l1_up(const Params& p, LAS uchar* lds, int parts = 7) {
    const int tid = threadIdx.x, wave = __builtin_amdgcn_readfirstlane(tid >> 6), lane = tid & 63, r = lane & 31, h = lane >> 5, wf = wave >> 2, wt = wave & 3;
    const bf16_t* proj1 = (const bf16_t*)(p.ws + OFF_PROJ1);
    const float* ssq64 = (const float*)(p.ws + OFF_SSQ64);
    const f32x4* ropec = (const f32x4*)(p.ws + OFF_ROPEC);
    const int nGp = 1056;
    const XTiles xq(4, NT / 128), xkv(8, NT / 256);
    const int nQl = (xq.count - xq.lb + xq.nlb - 1) / xq.nlb, nKVl = (xkv.count - xkv.lb + xkv.nlb - 1) / xkv.nlb;
    const int nGl = (nGp - (int)blockIdx.x + (int)gridDim.x - 1) / (int)gridDim.x;
    if (parts & 1) for (int it = 0; it < nQl; ++it) {
        {
            int ft, tt; xq.get(xq.lb + it * xq.nlb, ft, tt);
            f32x16 acc[3][1];
            gemm_block<3, 1, 3>(lds, (const bf16_t*)(p.ws + OFF_WQUP) + (size_t)ft * 192 * 256, 256, proj1 + (size_t)tt * 128 * 2048, 2048, 256, acc);
            const int hd = ft * 2 + wf;
            const int tok = tt * 128 + wt * 32 + r;
            const int b = tok / TPB, ti = tok - b * TPB; const bool isx = ti >= LCTX; const int pos = ti - LCTX;
            const f32x4 sq = *(const f32x4*)(ssq64 + (size_t)tok * 8);
            const float rcq = rsqrtf((sq[0] + sq[1] + sq[2] + sq[3]) * (1.0f / 256.0f) + EPS);
            float ss = 0.f;
#pragma unroll
            for (int i = 0; i < 3; ++i)
#pragma unroll
                for (int e = 0; e < 16; ++e) { acc[i][0][e] *= rcq; ss += acc[i][0][e] * acc[i][0][e]; }
            ss += __shfl_xor(ss, 32);
            const float rstd = rsqrtf(ss * (1.0f / 96.0f) + EPS);
            const float qs = 0.10206207261596575f * LOG2E;
            bf16_t* dn = (bf16_t*)(p.ws + OFF_CQN) + ((size_t)(b * 8 + hd) * TPB + ti) * 64;
            bf16_t* dr = (bf16_t*)(p.ws + OFF_CQR) + ((size_t)(b * 8 + hd) * TPB + ti) * 32;
#pragma unroll
            for (int i = 0; i < 3; ++i)
#pragma unroll
                for (int g4 = 0; g4 < 4; ++g4) {
                    const int d = i * 32 + 8 * g4 + 4 * h;
                    const f32x4 gg = *(const f32x4*)(p.c_qn + d);
                    float y0 = acc[i][0][4 * g4] * rstd * gg[0], y1 = acc[i][0][4 * g4 + 1] * rstd * gg[1];
                    float y2 = acc[i][0][4 * g4 + 2] * rstd * gg[2], y3 = acc[i][0][4 * g4 + 3] * rstd * gg[3];
                    if (i == 2 && isx) {
                        const f32x4 cs = ropec[((size_t)pos * 16 + ((d - 64) >> 1)) >> 1];
                        const float z0 = y0 * cs[0] - y1 * cs[1], z1 = y0 * cs[1] + y1 * cs[0];
                        const float z2 = y2 * cs[2] - y3 * cs[3], z3 = y2 * cs[3] + y3 * cs[2];
                        y0 = z0; y1 = z1; y2 = z2; y3 = z3;
                    }
                    const u32x2 w = (u32x2){pk2(y0 * qs, y1 * qs), pk2(y2 * qs, y3 * qs)};
                    if (i < 2) *(u32x2*)(dn + d) = w; else *(u32x2*)(dr + (d - 64)) = w;
                }
        }
    }
    if (parts & 2) for (int it = 0; it < nKVl; ++it) {
        {
            int hd, tt; xkv.get(xkv.lb + it * xkv.nlb, hd, tt);
            f32x16 acc[2][2];
            gemm_block<2, 2, 2>(lds, (const bf16_t*)(p.ws + OFF_WKVUP) + (size_t)hd * 128 * 128, 128, proj1 + (size_t)tt * 256 * 2048 + 256, 2048, 128, acc);
#pragma unroll
            for (int j = 0; j < 2; ++j) {
                const int tok = tt * 256 + wt * 64 + j * 32 + r;
                const int b = tok / TPB, ti = tok - b * TPB; const bool isx = ti >= LCTX; const int pos = ti - LCTX;
                const float rckv = rsqrtf((ssq64[(size_t)tok * 8 + 4] + ssq64[(size_t)tok * 8 + 5]) * (1.0f / 128.0f) + EPS);
                if (wf == 0) {
                    float ssn = 0.f;
#pragma unroll
                    for (int i = 0; i < 2; ++i)
#pragma unroll
                        for (int e = 0; e < 16; ++e) { acc[i][j][e] *= rckv; ssn += acc[i][j][e] * acc[i][j][e]; }
                    const u32x4* kp = (const u32x4*)(proj1 + (size_t)tok * 2048 + 1920 + 16 * h);
                    const u32x4 k0 = kp[0], k1 = kp[1];
                    float kpe[16] = {bflo(k0.x), bfhi(k0.x), bflo(k0.y), bfhi(k0.y), bflo(k0.z), bfhi(k0.z), bflo(k0.w), bfhi(k0.w),
                                     bflo(k1.x), bfhi(k1.x), bflo(k1.y), bfhi(k1.y), bflo(k1.z), bfhi(k1.z), bflo(k1.w), bfhi(k1.w)};
#pragma unroll
                    for (int e = 0; e < 16; ++e) ssn += kpe[e] * kpe[e];
                    ssn += __shfl_xor(ssn, 32);
                    const float rstd = rsqrtf(ssn * (1.0f / 96.0f) + EPS);
                    bf16_t* dn = (bf16_t*)(p.ws + OFF_CKN) + ((size_t)(b * 8 + hd) * TPB + ti) * 64;
                    bf16_t* dr = (bf16_t*)(p.ws + OFF_CKR) + ((size_t)(b * 8 + hd) * TPB + ti) * 32 + 16 * h;
#pragma unroll
                    for (int i = 0; i < 2; ++i)
#pragma unroll
                        for (int g4 = 0; g4 < 4; ++g4) {
                            const int d = i * 32 + 8 * g4 + 4 * h;
                            const f32x4 gg = *(const f32x4*)(p.c_kn + d);
                            *(u32x2*)(dn + d) = (u32x2){pk2(acc[i][j][4 * g4] * rstd * gg[0], acc[i][j][4 * g4 + 1] * rstd * gg[1]),
                                                         pk2(acc[i][j][4 * g4 + 2] * rstd * gg[2], acc[i][j][4 * g4 + 3] * rstd * gg[3])};
                        }
                    unsigned ow[8];
#pragma unroll
                    for (int m = 0; m < 8; ++m) {
                        float y0 = kpe[2 * m] * p.c_kn[64 + 16 * h + 2 * m] * rstd, y1 = kpe[2 * m + 1] * p.c_kn[64 + 16 * h + 2 * m + 1] * rstd;
                        if (isx) {
                            const f32x2 cs = ((const f32x2*)(p.ws + OFF_ROPEC))[(size_t)pos * 16 + 8 * h + m];
                            const float z0 = y0 * cs[0] - y1 * cs[1], z1 = y0 * cs[1] + y1 * cs[0];
                            y0 = z0; y1 = z1;
                        }
                        ow[m] = pk2(y0, y1);
                    }
                    *(u32x4*)(dr) = (u32x4){ow[0], ow[1], ow[2], ow[3]};
                    *(u32x4*)(dr + 8) = (u32x4){ow[4], ow[5], ow[6], ow[7]};
                } else {
                    bf16_t* dst = (bf16_t*)(p.ws + OFF_CVT) + (size_t)(b * 8 + hd) * 64 * TPB;
                    const int tp = perm16(ti);
#pragma unroll
                    for (int i = 0; i < 2; ++i)
#pragma unroll
                        for (int e = 0; e < 16; ++e) dst[(size_t)(i * 32 + crow(e, h)) * TPB + tp] = f2bf(acc[i][j][e] * rckv);
                }
            }
        }
    }
    if (parts & 4) for (int it = 0; it < nGl; ++it) {
        gla_g1_unit(p, lds + (tid >> 8) * 69632, 2 * ((int)blockIdx.x + it * (int)gridDim.x) + (tid >> 8));
        __syncthreads();
    }
}

DI void phase_attn_l1(const Params& p, LAS uchar* lds, bool do_scan = true) {
    const int tid = threadIdx.x, wave = __builtin_amdgcn_readfirstlane(tid >> 6), lane = tid & 63, r = lane & 31, h = lane >> 5;
    bf16_t* aout = (bf16_t*)(p.ws + OFF_AOUT);
    const int xcd = blockIdx.x & 7, lb = blockIdx.x >> 3, nlb = gridDim.x >> 3;
    const int nCl = (32 - lb + nlb - 1) / nlb;
    const int nS = do_scan ? (256 - (int)blockIdx.x + (int)gridDim.x - 1) / (int)gridDim.x : 0;
    for (int it = 0; it < nCl + nS; ++it) {
        if (it < nCl) {
            const int u = lb + it * nlb;
            const int combo = xcd + 8 * (u >> 4);
            const int b = combo >> 3, hd = combo & 7, q0 = LCTX + (u & 15) * 512;
            const size_t pl = (size_t)(b * 8 + hd);
            const bf16_t* qw = (const bf16_t*)(p.ws + OFF_CQN) + (pl * TPB + q0 + wave * 64) * 64;
            const bf16_t* qrw = (const bf16_t*)(p.ws + OFF_CQR) + (pl * TPB + q0 + wave * 64) * 32;
            const bf16_t* kb = (const bf16_t*)(p.ws + OFF_CKN) + pl * TPB * 64;
            const bf16_t* krb = (const bf16_t*)(p.ws + OFF_CKR) + pl * TPB * 32;
            const bf16_t* vtb = (const bf16_t*)(p.ws + OFF_CVT) + pl * 64 * TPB;
            f32x16 O[2][2]; float l[2];
            attn_core_q2<true, 2>(lds, qw, qrw, kb, krb, vtb, NCHUNK, O, l);
#pragma unroll
            for (int g = 0; g < 2; ++g) {
                const float inv = 1.0f / l[g];
                const int tok = b * TPB + q0 + wave * 64 + g * 32 + r;
                bf16_t* dst = aout + (size_t)tok * DM + hd * 64;
#pragma unroll
                for (int d = 0; d < 2; ++d)
#pragma unroll
                    for (int g4 = 0; g4 < 4; ++g4) {
                        const int dv = d * 32 + 8 * g4 + 4 * h;
                        *(u32x2*)(dst + dv) = (u32x2){pk2(O[g][d][4 * g4] * inv, O[g][d][4 * g4 + 1] * inv), pk2(O[g][d][4 * g4 + 2] * inv, O[g][d][4 * g4 + 3] * inv)};
                    }
            }
        } else {
            gla_scan_task(p, (int)blockIdx.x + (it - nCl) * (int)gridDim.x);
        }
    }
}
DI void phase_gla_out(const Params& p, LAS uchar* lds) {
    for (int v = blockIdx.x; v < NB * 4 * 64; v += gridDim.x) gla_g3_unit(p, lds + (threadIdx.x >> 8) * 69632, 2 * v + (int)(threadIdx.x >> 8));
}

#define XB_TMO      128
#define XB_XCNT(j)  (256  + 64 * (j))
#define XB_XSUB(j)  (1280 + 64 * (j))
#define XB_XGEN(j)  (2304 + 64 * (j))
#define XB_TOP      3328
#define XB_TOPGEN   3392
#define XB_SPIN_CAP (1u << 22)
DI unsigned xb_ld(unsigned* p) { return __hip_atomic_load(p, __ATOMIC_RELAXED, __HIP_MEMORY_SCOPE_AGENT); }
DI unsigned xb_add(unsigned* p, unsigned v) { return __hip_atomic_fetch_add(p, v, __ATOMIC_RELAXED, __HIP_MEMORY_SCOPE_AGENT); }
DI unsigned xb_xcc_id() { return (unsigned)__builtin_amdgcn_s_getreg((3 << 11) | 20) & 0xFu; }
#define XB_SPIN(cond, bar) do { unsigned _sp = 0; while (cond) { __builtin_amdgcn_s_sleep(1); \
    if ((++_sp & 255u) == 0u) { if (xb_ld(&(bar)[XB_TMO])) break; if (_sp > XB_SPIN_CAP) { atomicAdd(&(bar)[XB_TMO], 1u); break; } } } } while (0)
struct XcdBarrier { unsigned* bar; unsigned x; volatile LAS unsigned* st; };
DI XcdBarrier xcd_barrier_post(unsigned* bar, volatile LAS unsigned* st) {
    XcdBarrier b; b.bar = bar; b.x = xb_xcc_id(); b.st = st;
    if (threadIdx.x == 0) (void)xb_add(&bar[XB_XCNT(b.x)], 1u);
    return b;
}
DI void xcd_barrier_complete(unsigned* bar, unsigned x, unsigned& nloc, unsigned& nx) {
    const unsigned G = gridDim.x * gridDim.y * gridDim.z;
    unsigned sum, cnt, mine, sp = 0u;
    for (;;) {
        sum = 0u; cnt = 0u; mine = 0u;
#pragma unroll
        for (unsigned j = 0; j < 16; ++j) { const unsigned c = xb_ld(&bar[XB_XCNT(j)]); sum += c; cnt += (c > 0u) ? 1u : 0u; mine = (j == x) ? c : mine; }
        if (sum == G) break;
        __builtin_amdgcn_s_sleep(1);
        if ((++sp & 255u) == 0u) { if (xb_ld(&bar[XB_TMO])) break; if (sp > XB_SPIN_CAP) { atomicAdd(&bar[XB_TMO], 1u); break; } }
    }
    nloc = mine > 0u ? mine : 1u; nx = cnt > 0u ? cnt : 1u;
}
DI void xcd_barrier(const XcdBarrier& b) {
    asm volatile("s_waitcnt vmcnt(0)" ::: "memory");
    __syncthreads();
    if (threadIdx.x == 0) {
        unsigned* bar = b.bar;
        __builtin_amdgcn_s_waitcnt(0);
        unsigned nloc = b.st[0], nx = b.st[1];
        if (nloc == 0u) { xcd_barrier_complete(bar, b.x, nloc, nx); b.st[0] = nloc; b.st[1] = nx; }
        const unsigned old = xb_add(&bar[XB_XSUB(b.x)], 1u);
        const unsigned gen = old / nloc;
        if (old + 1u == (gen + 1u) * nloc) {
            __builtin_amdgcn_fence(__ATOMIC_RELEASE, "agent");
            asm volatile("s_waitcnt vmcnt(0)" ::: "memory");
            const unsigned og = xb_add(&bar[XB_TOP], 1u);
            const unsigned tg = og / nx;
            if (og + 1u == (tg + 1u) * nx) xb_add(&bar[XB_TOPGEN], 1u);
            else XB_SPIN(xb_ld(&bar[XB_TOPGEN]) == tg, bar);
            __builtin_amdgcn_fence(__ATOMIC_ACQUIRE, "agent");
            xb_add(&bar[XB_XGEN(b.x)], 1u);
            asm volatile("s_waitcnt vmcnt(0)" ::: "memory");
        } else {
            XB_SPIN(xb_ld(&bar[XB_XGEN(b.x)]) == gen, bar);
            __builtin_amdgcn_fence(__ATOMIC_ACQUIRE, "agent");
            asm volatile("s_waitcnt vmcnt(0)" ::: "memory");
        }
    }
    __syncthreads();
}

__global__ void __launch_bounds__(512, 2) fwd_megakernel(Params p) {
    __shared__ __attribute__((aligned(16))) uchar lds_raw[LDS_BYTES];
    LAS uchar* lds = (LAS uchar*)lds_raw;
    cg::grid_group grid = cg::this_grid();
    volatile LAS unsigned* xst = (volatile LAS unsigned*)(lds + LDS_BYTES - 16);
    if (threadIdx.x == 0) { xst[0] = 0u; xst[1] = 0u; }
    __syncthreads();
    const XcdBarrier xb = xcd_barrier_post((unsigned*)(p.ws + OFF_BAR), xst);
#define GRID_SYNC(N) do { if (p.phase_lo < 0) grid.sync(); xcd_barrier(xb); } while (0)
#define RUN_PHASE(N, CALL) if (p.phase_lo <= (N) && (N) < p.phase_hi) { if ((N) > p.phase_lo) GRID_SYNC(N); CALL; }
#ifdef ONLY_PHASE
#define PH(N, CALL) if ((N) == ONLY_PHASE) { RUN_PHASE(N, CALL) }
#else
#define PH(N, CALL) RUN_PHASE(N, CALL)
#endif
#ifdef DUP_PHASE
#define DUP(N, CALL) if (DUP_PHASE == (N)) { xcd_barrier(xb); CALL; }
#else
#define DUP(N, CALL)
#endif
    PH(0, phase_prep(p, lds))
    PH(1, phase_norm1_l0(p, lds))
    PH(2, phase_inproj_even(p, lds))
    PH(3, { phase_attn_l0(p, lds); conv_tables_dyn(p, lds, 0); })
    PH(4, phase_outproj(p, lds, 0, OFF_WOUTE, false))
    PH(5, phase_norm2(p, 0, false))
    PH(6, phase_peer_pq(p, lds, 0, false))
    PH(7, phase_peer_topk(p, lds, false))
    PH(8, phase_peer_gather(p, 0, false, false))
    PH(9, phase_inproj_odd(p, lds))
    PH(10, phase_l1_up(p, lds))
    PH(11, { phase_attn_l1(p, lds); conv_tables_dyn(p, lds, 1); })
    PH(12, phase_gla_out(p, lds))
    PH(13, phase_outproj(p, lds, 1, OFF_WOUTO, true))
    PH(14, phase_norm2(p, 1, true))
    PH(15, phase_peer_pq(p, lds, 1, true))
    PH(16, phase_peer_topk(p, lds, true))
    PH(17, phase_peer_gather(p, 1, true, true))
}

extern "C" void kernel_launch(void* const* d_in, const int* in_sizes, int n_in, void* d_out, int out_size, void* d_ws, size_t ws_size,
                              hipStream_t stream) {
    static int grid_blocks = 0;
    if (!grid_blocks) {
        int dev = 0, cus = 0, per_cu = 0;
        (void)hipGetDevice(&dev);
        (void)hipDeviceGetAttribute(&cus, hipDeviceAttributeMultiprocessorCount, dev);
        (void)hipOccupancyMaxActiveBlocksPerMultiprocessor(&per_cu, fwd_megakernel, NTHR, 0);
        if (per_cu > 1) per_cu = 1;
        if (per_cu < 1) per_cu = 1;
        grid_blocks = cus * per_cu;
    }
    Params p{};
    const float** fp = (const float**)&p;
    for (int i = 0; i < 37; ++i) fp[i] = (const float*)d_in[i];
    p.out = (float*)d_out;
    p.ws = (uchar*)d_ws;
    if (ws_size < WS_NEEDED) { fprintf(stderr, "workspace too small: %zu < %zu\n", ws_size, (size_t)WS_NEEDED); }
#if MULTI_LAUNCH
    for (int ph = 0; ph < N_PHASES_RUN; ++ph) {
        p.phase_lo = ph; p.phase_hi = ph + 1;
        hipLaunchKernelGGL(fwd_megakernel, dim3(grid_blocks), dim3(NTHR), 0, stream, p);
    }
#else
    p.phase_lo = 0; p.phase_hi = N_PHASES_RUN;
    (void)hipMemsetAsync((uchar*)d_ws + OFF_BAR, 0, 16384, stream);
    void* args[] = {&p};
    hipError_t e = hipLaunchCooperativeKernel((void*)fwd_megakernel, dim3(grid_blocks), dim3(NTHR), args, 0, stream);
    if (e != hipSuccess) fprintf(stderr, "cooperative launch failed: %s (grid %d)\n", hipGetErrorString(e), grid_blocks);
#endif
}
```

```cpp
#include <hip/hip_runtime.h>
#include <hip/hip_cooperative_groups.h>
#include <cstdio>
#include <cstdint>
#include <cmath>
namespace cg = cooperative_groups;

#ifndef N_PHASES_RUN
#define N_PHASES_RUN 16
#endif
#ifndef MULTI_LAUNCH
#define MULTI_LAUNCH 0
#endif

typedef unsigned short bf16_t;
typedef unsigned char uchar;
typedef short bf16x8 __attribute__((ext_vector_type(8)));
typedef float f32x16 __attribute__((ext_vector_type(16)));
typedef float f32x4 __attribute__((ext_vector_type(4)));
typedef float f32x2 __attribute__((ext_vector_type(2)));
typedef unsigned u32x4 __attribute__((ext_vector_type(4)));
typedef unsigned u32x2 __attribute__((ext_vector_type(2)));
typedef __bf16 bf16x2v __attribute__((ext_vector_type(2)));
#define LAS __attribute__((address_space(3)))
#define DI __device__ __forceinline__

constexpr int DM = 1024, NB = 2, SEQ = 8192, LCTX = 256, TPB = SEQ + LCTX  , NT = NB * TPB  ;
constexpr float EPS = 1e-6f;
constexpr float LOG2E = 1.4426950408889634f;
constexpr int KSPLIT = 32;
constexpr int NCHUNK = TPB / 64;

constexpr size_t al256(size_t x) { return (x + 255) & ~(size_t)255; }
constexpr size_t OFF_WINE = 0;
constexpr size_t OFF_WOUTE = OFF_WINE + (size_t)2304 * 1024 * 2;
constexpr size_t OFF_WINO = OFF_WOUTE + (size_t)1024 * 1024 * 2;
constexpr size_t OFF_WOUTO = OFF_WINO + (size_t)2048 * 1024 * 2;
constexpr size_t OFF_WQUP = OFF_WOUTO + (size_t)1024 * 1024 * 2;
constexpr size_t OFF_WKVUP = OFF_WQUP + (size_t)768 * 256 * 2;
constexpr size_t OFF_PWQ = OFF_WKVUP + (size_t)1024 * 128 * 2;
constexpr size_t OFF_PKEYS = OFF_PWQ + (size_t)2 * 2048 * 1024 * 2;
constexpr size_t OFF_PU = OFF_PKEYS + (size_t)2 * 16 * 128 * 128 * 2;
constexpr size_t OFF_RESB = OFF_PU + (size_t)2 * 16384 * 512;
constexpr size_t OFF_PV = OFF_PU + (size_t)2 * 16384 * 1024 * 2;
constexpr size_t OFF_MODPART = OFF_PV + (size_t)2 * 16384 * 1024 * 2;
constexpr size_t OFF_MOD = OFF_MODPART + (size_t)KSPLIT * 36864 * 4;
constexpr size_t OFF_ROPEAB = OFF_MOD + (size_t)36864 * 4;
constexpr size_t OFF_ROPEC = OFF_ROPEAB + (size_t)8192 * 64 * 4;
constexpr size_t OFF_SCAL = OFF_ROPEC + (size_t)8192 * 32 * 4;
constexpr size_t OFF_BAR = OFF_SCAL + 256;
constexpr size_t OFF_HRES = OFF_BAR + 16384;
constexpr size_t OFF_HBF = OFF_HRES + (size_t)512 * 1024 * 4;
constexpr size_t OFF_AOUT = OFF_HBF + (size_t)NT * 1024 * 2;
constexpr size_t OFF_SSQ64 = OFF_AOUT + (size_t)NT * 1024 * 2;
constexpr size_t OFF_ATT = OFF_SSQ64 + (size_t)NT * 8 * 4;
constexpr size_t SZ_QK64 = (size_t)TPB * 64 * 2;
constexpr size_t OFF_AQ = OFF_ATT;
constexpr size_t OFF_AK = OFF_AQ + 16 * SZ_QK64;
constexpr size_t OFF_AVT = OFF_AK + 16 * SZ_QK64;
constexpr size_t OFF_BQ = OFF_AVT + (size_t)8 * 128 * TPB * 2;
constexpr size_t OFF_BK = OFF_BQ + 16 * SZ_QK64;
constexpr size_t OFF_BVT = OFF_BK + 4 * SZ_QK64;
constexpr size_t OFF_ATT_END0 = OFF_BVT + (size_t)4 * 64 * TPB * 2;
constexpr size_t SZ_QK32 = (size_t)TPB * 32 * 2;
constexpr size_t OFF_CQN = OFF_ATT;
constexpr size_t OFF_CQR = OFF_CQN + 16 * SZ_QK64;
constexpr size_t OFF_CKN = OFF_CQR + 16 * SZ_QK32;
constexpr size_t OFF_CKR = OFF_CKN + 16 * SZ_QK64;
constexpr size_t OFF_CVT = OFF_CKR + 16 * SZ_QK32;
constexpr size_t OFF_ATT_END1 = OFF_CVT + (size_t)16 * 64 * TPB * 2;
constexpr size_t OFF_R1 = (OFF_ATT_END0 > OFF_ATT_END1 ? OFF_ATT_END0 : OFF_ATT_END1);
constexpr size_t OFF_SCORES = OFF_R1;
constexpr size_t OFF_PQ = OFF_R1 + (size_t)NT * 2048 * 2;
constexpr size_t OFF_AVT8 = OFF_PQ + (size_t)32 * 1024 * 1024;
constexpr size_t OFF_AK8 = OFF_AVT8 + (size_t)8 * 128 * TPB;
constexpr size_t OFF_BK8 = OFF_AK8 + (size_t)8 * 2 * TPB * 64;
constexpr size_t OFF_BVT8 = OFF_BK8 + (size_t)4 * TPB * 64;
constexpr size_t OFF_H8 = OFF_PQ;
constexpr size_t OFF_PROJ1 = OFF_R1;
constexpr size_t OFF_GDS = OFF_PROJ1 + (size_t)NT * 2048 * 2;
constexpr size_t OFF_GDEC = OFF_GDS + (size_t)2112 * 8192 * 4;
constexpr size_t OFF_R1_END_A = OFF_SCORES + (size_t)NT * 2048 * 4;
constexpr size_t OFF_R1_END_B = OFF_GDEC + (size_t)2112 * 64 * 4;
constexpr size_t OFF_EIDX = (OFF_R1_END_A > OFF_R1_END_B ? OFF_R1_END_A : OFF_R1_END_B);
constexpr size_t OFF_GATE = OFF_EIDX + (size_t)NT * 128 * 2;
constexpr size_t WS_NEEDED = OFF_GATE + (size_t)NT * 128 * 4;

constexpr int NTHR = 512, NW = 8;
constexpr int LDS_BYTES = 147456 + 16;

struct Params {
    const float *x, *c, *ctx, *c_ctx, *w_mod, *b_mod, *norm1, *norm2, *e_w_in, *e_w_out, *a_qn, *a_kn, *a_lq1, *a_lk1, *a_lq2, *a_lk2,
        *a_gn, *b_qn, *b_kn, *b_sink, *o_w_in, *o_w_out, *c_gq, *c_gkv, *c_wq_up, *c_wkv_up, *c_qn, *c_kn, *d_wg_f, *d_bg_f, *d_wg_b,
        *d_bg_b, *d_gn, *p_wq, *p_keys, *p_u, *p_v;
    float* out;
    uchar* ws;
    int phase_lo, phase_hi;
};

DI unsigned pk2(float a, float b) { return __builtin_bit_cast(unsigned, __builtin_convertvector((f32x2){a, b}, bf16x2v)); }
typedef int i32x8 __attribute__((ext_vector_type(8)));
typedef long i64x2 __attribute__((ext_vector_type(2)));
DI float bflo(unsigned u) { return __uint_as_float(u << 16); }
DI float bfhi(unsigned u) { return __uint_as_float(u & 0xffff0000u); }
DI float bf2f(bf16_t v) { return __uint_as_float(((unsigned)v) << 16); }
DI bf16_t f2bf(float f) { return (bf16_t)(pk2(f, 0.f) & 0xffffu); }
DI int crow(int reg, int h) { return (reg & 3) + 8 * (reg >> 2) + 4 * h; }
DI int perm16(int t) { return (t & ~12) | ((t & 4) << 1) | ((t & 8) >> 1); }
DI float wave_sum(float v) {
#pragma unroll
    for (int o = 32; o >= 1; o >>= 1) v += __shfl_xor(v, o);
    return v;
}
DI float wave_max(float v) {
#pragma unroll
    for (int o = 32; o >= 1; o >>= 1) v = fmaxf(v, __shfl_xor(v, o));
    return v;
}
DI float silu_f(float x) { return x / (1.f + __expf(-x)); }
#define MFMA32(a, b, c) __builtin_amdgcn_mfma_f32_32x32x16_bf16((a), (b), (c), 0, 0, 0)

DI const float* in_row(const Params& p, int tok) {
    const int b = tok / TPB, i = tok - b * TPB;
    return i < LCTX ? p.ctx + ((size_t)b * LCTX + i) * DM : p.x + ((size_t)b * SEQ + (i - LCTX)) * DM;
}
DI float* res_row(const Params& p, int tok) {
    const int b = tok / TPB, i = tok - b * TPB;
    return i < LCTX ? (float*)(p.ws + OFF_HRES) + ((size_t)b * LCTX + i) * DM : p.out + ((size_t)b * SEQ + (i - LCTX)) * DM;
}
DI bf16_t* resb_row(const Params& p, int tok) { return (bf16_t*)(p.ws + OFF_RESB) + (size_t)tok * DM; }
DI f32x4 ld4bf(const bf16_t* q) { const u32x2 v = *(const u32x2*)q; return (f32x4){bflo(v.x), bfhi(v.x), bflo(v.y), bfhi(v.y)}; }
DI void st4bf(bf16_t* q, f32x4 v) { *(u32x2*)q = (u32x2){pk2(v[0], v[1]), pk2(v[2], v[3])}; }
DI int mod_id(int tok) { const int b = tok / TPB, i = tok - b * TPB; return i < LCTX ? 2 : b; }

DI unsigned t128_off(int row, int chunk) { return (unsigned)(row * 128 + ((chunk ^ ((row >> 1) & 7)) << 4)); }
DI unsigned t64_off(int row, int chunk) { return (unsigned)(row * 64 + ((chunk ^ ((row >> 2) & 3)) << 4)); }
DI bf16x8 ldsfrag(const LAS uchar* base, unsigned off) { return *(const LAS bf16x8*)(base + off); }

DI void dma_t128(LAS uchar* lds, const uchar* g, size_t gstride, int nrows, int wave, int lane) {
    const int rin = lane >> 3, cpos = lane & 7;
    for (int r0 = wave * 8; r0 < nrows; r0 += 8 * NW) {
        const int row = r0 + rin;
        const int sc = cpos ^ ((row >> 1) & 7);
        __builtin_amdgcn_global_load_lds((const unsigned*)(g + (size_t)row * gstride + sc * 16), (LAS unsigned*)(lds + r0 * 128), 16, 0, 0);
    }
}
DI void dma_t64(LAS uchar* lds, const uchar* g, size_t gstride, int wave, int lane) {
    if (lane < 32) {
        const int row = wave * 8 + (lane >> 2), cpos = lane & 3;
        const int sc = cpos ^ ((row >> 2) & 3);
        __builtin_amdgcn_global_load_lds((const unsigned*)(g + (size_t)row * gstride + sc * 16), (LAS unsigned*)(lds + wave * 512), 16, 0, 0);
    }
}
#define WAIT_VM0() asm volatile("s_waitcnt vmcnt(0)" ::: "memory")
template <int N> DI void wait_vmcnt() { asm volatile("s_waitcnt vmcnt(%0)" ::"n"(N) : "memory"); }
#define LDS_SYNC() do { asm volatile("s_waitcnt lgkmcnt(0)" ::: "memory"); __builtin_amdgcn_s_barrier(); asm volatile("" ::: "memory"); } while (0)
#define RAW_BAR() do { asm volatile("" ::: "memory"); __builtin_amdgcn_s_barrier(); asm volatile("" ::: "memory"); } while (0)

DI int grp_row(int f) { const int fl = f & 255; return (f & ~255) + 128 * ((fl >> 5) & 1) + 32 * (fl >> 6) + (fl & 31); }
struct RowId { DI int operator()(int r) const { return r; } };
struct RowGrp { int base; DI int operator()(int r) const { return grp_row(base + r); } };
template <int WM, int WN, int NST, class RowMap = RowId, bool F8 = false>
DI void gemm_block(LAS uchar* lds, const bf16_t* Wt, int ldw, const bf16_t* X, int ldx, int K, f32x16 (&acc)[WM][WN], RowMap rm = RowMap()) {
    constexpr int FB = 64 * WM, TB = 128 * WN, STG = (FB + TB) * 128, NDMA = FB / 64 + TB / 64;
    static_assert(NST * STG <= 147456, "LDS");
    const int tid = threadIdx.x, wave = __builtin_amdgcn_readfirstlane(tid >> 6), lane = tid & 63, r = lane & 31, h = lane >> 5, wf = wave >> 2, wt = wave & 3;
#pragma unroll
    for (int i = 0; i < WM; ++i)
#pragma unroll
        for (int j = 0; j < WN; ++j)
#pragma unroll
            for (int e = 0; e < 16; ++e) acc[i][j][e] = 0.f;
    const int nk = K / 64;
    const int rin = lane >> 3, cpos = lane & 7;
    auto piece = [&](int kt, int st, int pc) {
        LAS uchar* sp = lds + st * STG;
        const bool isw = pc < FB / 64;
        const int r0 = (isw ? pc : pc - FB / 64) * 64 + wave * 8, row = r0 + rin, sc = cpos ^ ((row >> 1) & 7);
        const uchar* g = isw ? (const uchar*)(Wt + kt * 64) + (size_t)rm(row) * ((size_t)ldw * 2) : (const uchar*)(X + kt * 64) + (size_t)row * ((size_t)ldx * 2);
        __builtin_amdgcn_global_load_lds((const unsigned*)(g + sc * 16), (LAS unsigned*)(sp + (isw ? 0 : FB * 128) + r0 * 128), 16, 0, 0);
    };
#pragma unroll
    for (int s0 = 0; s0 < NST - 1; ++s0)
        if (s0 < nk) {
#pragma unroll
            for (int pc = 0; pc < NDMA; ++pc) piece(s0, s0, pc);
        }
    int cs = 0, is = NST - 1;
    for (int kt = 0; kt < nk; ++kt) {
        if (kt + NST - 2 < nk) wait_vmcnt<(NST - 2) * NDMA>(); else wait_vmcnt<0>();
        RAW_BAR();
        const bool more = kt + NST - 1 < nk;
        const LAS uchar* cur = lds + cs * STG;
#pragma unroll
        for (int kk = 0; kk < 4; ++kk) {
            bf16x8 a[WM], b[WN];
#pragma unroll
            for (int i = 0; i < WM; ++i) a[i] = ldsfrag(cur, t128_off(wf * WM * 32 + i * 32 + r, 2 * kk + h));
#pragma unroll
            for (int j = 0; j < WN; ++j) b[j] = ldsfrag(cur + FB * 128, t128_off(wt * WN * 32 + j * 32 + r, 2 * kk + h));
#pragma unroll
            for (int i = 0; i < WM; ++i)
#pragma unroll
                for (int j = 0; j < WN; ++j) {
                    if constexpr (F8) {
                        const i64x2 a2 = __builtin_bit_cast(i64x2, a[i]), b2 = __builtin_bit_cast(i64x2, b[j]);
                        acc[i][j] = __builtin_amdgcn_mfma_f32_32x32x16_fp8_fp8(a2[0], b2[0], acc[i][j], 0, 0, 0);
                        acc[i][j] = __builtin_amdgcn_mfma_f32_32x32x16_fp8_fp8(a2[1], b2[1], acc[i][j], 0, 0, 0);
                    } else acc[i][j] = MFMA32(a[i], b[j], acc[i][j]);
                }
            if (more) {
#pragma unroll
                for (int pc = kk * NDMA / 4; pc < (kk + 1) * NDMA / 4; ++pc) piece(kt + NST - 1, is, pc);
            }
        }
        cs = cs + 1 == NST ? 0 : cs + 1; is = is + 1 == NST ? 0 : is + 1;
    }
    if constexpr (F8) {
#pragma unroll
        for (int i = 0; i < WM; ++i)
#pragma unroll
            for (int j = 0; j < WN; ++j) acc[i][j] *= 0.0625f;
    }
    __syncthreads();
}

namespace pg8 {
#define PG8_LAS __attribute__((address_space(3)))
constexpr int BM = 256, BK = 64, HALF = 128, HTB = HALF * BK * 2  , STAGE_BYTES = 8 * HTB;
DI int lds_byte(int r, int c) { const int st = (r >> 4) * 2 + (c >> 5), rr = r & 15, cc = c & 31, ob = rr * 64 + cc * 2; return st * 1024 + (ob ^ (((ob >> 9) & 1) << 5)); }
DI void stage_rc(int b, int& R, int& C) { const int st = b / 1024, sb = b % 1024, swz = sb ^ (((sb >> 9) & 1) << 5); R = (st >> 1) * 16 + swz / 64; C = (st & 1) * 32 + (swz % 64) / 2; }
DI int perm32(int rho) { const int n = rho >> 4, i = rho & 15; return 8 * (i >> 2) + 4 * n + (i & 3); }
struct Unit { int pm, pn; };
struct Gemm { const bf16_t* A; const bf16_t* Bt; int M, N, K; };
template <class Epi, class Sched, bool ALIGN_EPI = false, bool SP2 = false, bool F8 = false>
__device__ __forceinline__ void gemm_phase(PG8_LAS unsigned char* lds, const Gemm g, const Sched& S, const Epi& E) {
    const int tid = threadIdx.x, wid = __builtin_amdgcn_readfirstlane(tid >> 6), lane = tid & 63, wr = wid >> 2, wc = wid & 3, fr = lane & 15, fq = lane >> 4;
    const int K = g.K, nt = K / BK;
    unsigned voffA[2], voffB[2];
#pragma unroll
    for (int i = 0; i < 2; ++i) { int R, C; stage_rc(tid * 16 + i * 8192, R, C); const int Rb = Epi::PERM ? ((R & ~31) + perm32(R & 31)) : R;
        voffA[i] = (unsigned)(R * K + C) * 2u; voffB[i] = (unsigned)(Rb * K + C) * 2u; }
    const size_t kstep = (size_t)(BK * 2);
    const size_t hstep = (size_t)HALF * K * 2;
    const size_t tstep = 2 * hstep;
    const unsigned ldsw = (unsigned)wid * 1024u;
    const int aoff = lds_byte(wr * 64 + fr, fq * 8), boff = lds_byte(wc * 32 + fr, fq * 8);
#define PG8_SA(b, h) (((b) * 2 + (h)) * HTB)
#define PG8_SB(b, h) ((4 + (b) * 2 + (h)) * HTB)
#define PG8_STAGE(bufoff, gbase, voff) do { _Pragma("unroll") for (int _i = 0; _i < 2; ++_i) \
        __builtin_amdgcn_global_load_lds((const unsigned*)((const char*)(gbase) + (voff)[_i]), (PG8_LAS unsigned*)(lds + (bufoff) + ldsw + _i * 8192), 16, 0, 0); } while (0)
#define PG8_LDA(dst, b, h) do { _Pragma("unroll") for (int m = 0; m < 4; ++m) _Pragma("unroll") for (int k = 0; k < 2; ++k) dst[m][k] = *(const PG8_LAS bf16x8*)(lds + PG8_SA(b, h) + aoff + m * 2048 + k * 1024); } while (0)
#define PG8_LDB(dst, b, h) do { _Pragma("unroll") for (int n = 0; n < 2; ++n) _Pragma("unroll") for (int k = 0; k < 2; ++k) dst[n][k] = *(const PG8_LAS bf16x8*)(lds + PG8_SB(b, h) + boff + n * 2048 + k * 1024); } while (0)
#define PG8_MMA(ai, bj, At, Bt) do { __builtin_amdgcn_s_setprio(1); _Pragma("unroll") for (int m = 0; m < 4; ++m) _Pragma("unroll") for (int n = 0; n < 2; ++n) _Pragma("unroll") for (int k = 0; k < 2; ++k) { \
        if constexpr (F8) { const i64x2 _b = __builtin_bit_cast(i64x2, Bt[n][k]), _a = __builtin_bit_cast(i64x2, At[m][k]); \
            acc[ai][bj][m][n] = __builtin_amdgcn_mfma_f32_16x16x32_fp8_fp8(_b[0], _a[0], acc[ai][bj][m][n], 0, 0, 0); \
            acc[ai][bj][m][n] = __builtin_amdgcn_mfma_f32_16x16x32_fp8_fp8(_b[1], _a[1], acc[ai][bj][m][n], 0, 0, 0); } \
        else acc[ai][bj][m][n] = __builtin_amdgcn_mfma_f32_16x16x32_bf16(Bt[n][k], At[m][k], acc[ai][bj][m][n], 0, 0, 0); } \
        __builtin_amdgcn_s_setprio(0); } while (0)
#define PG8_WAIT_V(n) asm volatile("s_waitcnt vmcnt(" #n ")" ::: "memory")
#define PG8_WAIT_L(n) asm volatile("s_waitcnt lgkmcnt(" #n ")" ::: "memory")
#define PG8_BAR __builtin_amdgcn_s_barrier()
#define PG8_SCHED __builtin_amdgcn_sched_barrier(0)
    Unit cur, nxt; int ui = 0;
    if (!S.next(0, cur)) return;
    f32x4 acc[2][2][4][2];
#pragma unroll
    for (int a = 0; a < 2; ++a)
#pragma unroll
        for (int b = 0; b < 2; ++b)
#pragma unroll
            for (int m = 0; m < 4; ++m)
#pragma unroll
                for (int n = 0; n < 2; ++n) acc[a][b][m][n] = (f32x4){0.f, 0.f, 0.f, 0.f};
    bf16x8 At[4][2], B0[2][2], B1[2][2];
    const char* cA = (const char*)g.A + (size_t)cur.pm * tstep; const char* cB = (const char*)g.Bt + (size_t)cur.pn * tstep;
    S.a_ready(cur);
    if constexpr (SP2) {
        PG8_STAGE(PG8_SB(0, 0), cB, voffB); PG8_STAGE(PG8_SB(0, 1), cB + hstep, voffB); PG8_STAGE(PG8_SA(0, 0), cA, voffA); PG8_STAGE(PG8_SA(0, 1), cA + hstep, voffA);
        if (wr == 1) PG8_BAR;
        PG8_WAIT_V(2); PG8_BAR;
        PG8_STAGE(PG8_SB(1, 0), cB + kstep, voffB); PG8_STAGE(PG8_SA(1, 0), cA + kstep, voffA); PG8_STAGE(PG8_SB(1, 1), cB + hstep + kstep, voffB);
        PG8_WAIT_V(6); PG8_BAR;
    } else {
        PG8_STAGE(PG8_SB(0, 0), cB, voffB); PG8_STAGE(PG8_SA(0, 0), cA, voffA); PG8_STAGE(PG8_SB(0, 1), cB + hstep, voffB); PG8_STAGE(PG8_SA(0, 1), cA + hstep, voffA);
        if (wr == 1) PG8_BAR;
        PG8_WAIT_V(4); PG8_BAR;
        PG8_STAGE(PG8_SB(1, 0), cB + kstep, voffB); PG8_STAGE(PG8_SA(1, 0), cA + kstep, voffA); PG8_STAGE(PG8_SB(1, 1), cB + hstep + kstep, voffB);
        PG8_WAIT_V(6); PG8_BAR;
    }
    for (;;) {
        const bool has_next = S.next(ui + 1, nxt);
        const char* nA = has_next ? (const char*)g.A + (size_t)nxt.pm * tstep : cA; const char* nB = has_next ? (const char*)g.Bt + (size_t)nxt.pn * tstep : cB;
        for (int t = 0; t < nt; t += 2) {
            const bool last = (t == nt - 2);
            const char* a1 = cA + (size_t)(t + 1) * kstep;
            const char* a2 = last ? nA : cA + (size_t)(t + 2) * kstep; const char* b2 = last ? nB : cB + (size_t)(t + 2) * kstep;
            const char* a3 = a2 + kstep; const char* b3 = b2 + kstep;
            if (last && has_next) S.a_ready(nxt);
            if constexpr (SP2) {
            PG8_LDB(B0, 0, 0); PG8_LDB(B1, 0, 1); PG8_SCHED; PG8_LDA(At, 0, 0); PG8_STAGE(PG8_SA(1, 1), a1 + hstep, voffA);
            PG8_WAIT_V(8); PG8_WAIT_L(0); PG8_BAR; PG8_MMA(0, 0, At, B0); PG8_MMA(0, 1, At, B1); PG8_BAR; PG8_SCHED;
            PG8_LDA(At, 0, 1); PG8_STAGE(PG8_SB(0, 0), b2, voffB); PG8_STAGE(PG8_SB(0, 1), b2 + hstep, voffB); PG8_STAGE(PG8_SA(0, 0), a2, voffA);
            PG8_WAIT_V(8); PG8_WAIT_L(0); PG8_BAR; PG8_MMA(1, 0, At, B0); PG8_MMA(1, 1, At, B1); PG8_BAR; PG8_SCHED;
            PG8_LDB(B0, 1, 0); PG8_LDB(B1, 1, 1); PG8_SCHED; PG8_LDA(At, 1, 0); PG8_STAGE(PG8_SA(0, 1), a2 + hstep, voffA);
            PG8_WAIT_V(8); PG8_WAIT_L(0); PG8_BAR; PG8_MMA(0, 0, At, B0); PG8_MMA(0, 1, At, B1); PG8_BAR; PG8_SCHED;
            PG8_LDA(At, 1, 1); PG8_STAGE(PG8_SB(1, 0), b3, voffB); PG8_STAGE(PG8_SB(1, 1), b3 + hstep, voffB); PG8_STAGE(PG8_SA(1, 0), a3, voffA);
            PG8_WAIT_V(8); PG8_WAIT_L(0); PG8_BAR; PG8_MMA(1, 0, At, B0); PG8_MMA(1, 1, At, B1); PG8_BAR; PG8_SCHED;
            } else {
            PG8_LDB(B0, 0, 0); PG8_SCHED; PG8_LDA(At, 0, 0); PG8_STAGE(PG8_SA(1, 1), a1 + hstep, voffA);
            PG8_WAIT_L(8); PG8_BAR; PG8_WAIT_L(0); PG8_MMA(0, 0, At, B0); PG8_BAR; PG8_SCHED;
            PG8_LDB(B1, 0, 1); PG8_STAGE(PG8_SB(0, 0), b2, voffB);
            PG8_BAR; PG8_WAIT_L(0); PG8_MMA(0, 1, At, B1); PG8_BAR;
            PG8_LDA(At, 0, 1); PG8_STAGE(PG8_SA(0, 0), a2, voffA);
            PG8_BAR; PG8_WAIT_L(0); PG8_MMA(1, 0, At, B0); PG8_BAR; PG8_SCHED;
            PG8_STAGE(PG8_SB(0, 1), b2 + hstep, voffB);
            PG8_WAIT_V(6); PG8_BAR; PG8_MMA(1, 1, At, B1); PG8_BAR;
            PG8_LDB(B0, 1, 0); PG8_SCHED; PG8_LDA(At, 1, 0); PG8_STAGE(PG8_SA(0, 1), a2 + hstep, voffA);
            PG8_WAIT_L(8); PG8_BAR; PG8_WAIT_L(0); PG8_MMA(0, 0, At, B0); PG8_BAR; PG8_SCHED;
            PG8_LDB(B1, 1, 1); PG8_STAGE(PG8_SB(1, 0), b3, voffB);
            PG8_BAR; PG8_WAIT_L(0); PG8_MMA(0, 1, At, B1); PG8_BAR;
            PG8_LDA(At, 1, 1); PG8_STAGE(PG8_SA(1, 0), a3, voffA);
            PG8_BAR; PG8_WAIT_L(0); PG8_MMA(1, 0, At, B0); PG8_BAR; PG8_SCHED;
            PG8_STAGE(PG8_SB(1, 1), b3 + hstep, voffB);
            PG8_WAIT_V(6); PG8_BAR; PG8_MMA(1, 1, At, B1); PG8_BAR;
            }
        }
        if constexpr (ALIGN_EPI) { if (wr == 0) PG8_BAR; }
        if constexpr (F8) {
#pragma unroll
            for (int a = 0; a < 2; ++a)
#pragma unroll
                for (int b = 0; b < 2; ++b)
#pragma unroll
                    for (int m = 0; m < 4; ++m)
#pragma unroll
                        for (int n = 0; n < 2; ++n) acc[a][b][m][n] *= 0.0625f;
        }
        if constexpr (!Epi::AFTER_DRAIN) { E(acc, cur, wr, wc, fr, fq); S.done(cur); }
        if (!has_next) break;
#pragma unroll
        for (int a = 0; a < 2; ++a)
#pragma unroll
            for (int b = 0; b < 2; ++b)
#pragma unroll
                for (int m = 0; m < 4; ++m)
#pragma unroll
                    for (int n = 0; n < 2; ++n) acc[a][b][m][n] = (f32x4){0.f, 0.f, 0.f, 0.f};
        cur = nxt; cA = nA; cB = nB; ++ui;
        if constexpr (ALIGN_EPI) { if (wr == 1) PG8_BAR; }
    }
    PG8_WAIT_V(0);
    if constexpr (!ALIGN_EPI) { if (wr == 0) PG8_BAR; }
    PG8_BAR;
    if constexpr (Epi::AFTER_DRAIN) { E.fused(acc, cur, wr, wc, fr, fq, lds, wid, lane); S.done(cur); }
#undef PG8_SA
#undef PG8_SB
#undef PG8_STAGE
#undef PG8_LDA
#undef PG8_LDB
#undef PG8_MMA
#undef PG8_WAIT_V
#undef PG8_WAIT_L
#undef PG8_BAR
#undef PG8_SCHED
}
}

struct TileOrder {
    int nN, nU; bool xonly;
    DI bool next(int i, pg8::Unit& u) const {
        const int L = i * (int)gridDim.x + (int)blockIdx.x; if (L >= nU) return false;
        const int t = L / nN; u.pn = L - t * nN; u.pm = xonly ? t + 1 + (t >= 32 ? 1 : 0) : t; return true;
    }
    DI void a_ready(const pg8::Unit&) const {}
    DI void done(const pg8::Unit&) const {}
};

struct XTiles {
    int nFl, f0, nTl, t0, lb, nlb, count;
    DI XTiles(int nF, int nT) {
        const int x = blockIdx.x & 7; lb = blockIdx.x >> 3; nlb = gridDim.x >> 3;
        const int fg = x & 1, tg = x >> 1;
        nFl = nF >> 1; f0 = fg * nFl;
        const int q = nT >> 2, r = nT & 3;
        nTl = q + (tg < r ? 1 : 0); t0 = tg * q + (tg < r ? tg : r);
        count = nFl * nTl;
    }
    DI void get(int idx, int& ft, int& tt) const { ft = f0 + idx % nFl; tt = t0 + idx / nFl; }
};

template <class DMap, bool F8 = false>
DI void conv_tile(LAS float* sm, const float* src, int K, int N, bf16_t* dst, int k0, int n0, const float* kscale, DMap dmap) {
    const int tid = threadIdx.x;
    __syncthreads();
    for (int idx = tid; idx < 1024; idx += NTHR) {
        const int kr = idx >> 4, c4 = idx & 15;
        const int n = n0 + c4 * 4;
        f32x4 v = (f32x4){0.f, 0.f, 0.f, 0.f};
        if (n < N) v = *(const f32x4*)(src + (size_t)(k0 + kr) * N + n);
        const float s = kscale ? kscale[k0 + kr] : 1.f;
        sm[kr * 65 + c4 * 4 + 0] = v[0] * s; sm[kr * 65 + c4 * 4 + 1] = v[1] * s; sm[kr * 65 + c4 * 4 + 2] = v[2] * s; sm[kr * 65 + c4 * 4 + 3] = v[3] * s;
    }
    __syncthreads();
    for (int idx = tid; idx < 512; idx += NTHR) {
        const int nn = idx >> 3, kc = idx & 7;
        const int n = n0 + nn;
        if (n < N) {
            u32x4 w;
            w.x = pk2(sm[(kc * 8 + 0) * 65 + nn], sm[(kc * 8 + 1) * 65 + nn]);
            w.y = pk2(sm[(kc * 8 + 2) * 65 + nn], sm[(kc * 8 + 3) * 65 + nn]);
            w.z = pk2(sm[(kc * 8 + 4) * 65 + nn], sm[(kc * 8 + 5) * 65 + nn]);
            w.w = pk2(sm[(kc * 8 + 6) * 65 + nn], sm[(kc * 8 + 7) * 65 + nn]);
            if constexpr (F8) {
                int x0 = __builtin_amdgcn_cvt_pk_fp8_f32(16.f * sm[(kc * 8 + 0) * 65 + nn], 16.f * sm[(kc * 8 + 1) * 65 + nn], 0, false);
                x0 = __builtin_amdgcn_cvt_pk_fp8_f32(16.f * sm[(kc * 8 + 2) * 65 + nn], 16.f * sm[(kc * 8 + 3) * 65 + nn], x0, true);
                int x1 = __builtin_amdgcn_cvt_pk_fp8_f32(16.f * sm[(kc * 8 + 4) * 65 + nn], 16.f * sm[(kc * 8 + 5) * 65 + nn], 0, false);
                x1 = __builtin_amdgcn_cvt_pk_fp8_f32(16.f * sm[(kc * 8 + 6) * 65 + nn], 16.f * sm[(kc * 8 + 7) * 65 + nn], x1, true);
                *(u32x2*)((uchar*)dst + (size_t)dmap(n) * K + k0 + kc * 8) = (u32x2){(unsigned)x0, (unsigned)x1};
            } else
            *(u32x4*)(dst + (size_t)dmap(n) * K + k0 + kc * 8) = w;
        }
    }
}
struct IdMap { DI int operator()(int n) const { return n; } };
struct GrpMap { DI int operator()(int n) const { return grp_row(n); } };
struct OddMap {
    DI int col(int n) const {
        if (n < 384) return n;
        if (n < 416) return 1920 + (n - 384);
        if (n < 1440) return n - 32;
        if (n < 1456) return 1952 + (n - 1440);
        if (n < 1472) return 1968 + (n - 1456);
        return n - 64;
    }
    DI int operator()(int n) const { return grp_row(col(n)); }
};

DI void wsk_tile(const Params& p, LAS uchar* lds, int t) {
    const int tid = threadIdx.x, wave = __builtin_amdgcn_readfirstlane(tid >> 6), lane = tid & 63, r = lane & 31, h = lane >> 5, wf = wave >> 2, wt = wave & 3;
    const int l = t >> 7, g = (t >> 3) & 15, kt = t & 7;
    const float* wq = p.p_wq + (size_t)l * 1024 * 2048 + (size_t)kt * 128 * 2048 + g * 128;
    const float* ky = p.p_keys + ((size_t)l * 16 + g) * 128 * 128;
#pragma unroll
    for (int q = 0; q < 4; ++q) {
        const int i = tid + q * NTHR, row = i >> 4, c = i & 15;
        const f32x4 a = *(const f32x4*)(wq + (size_t)row * 2048 + c * 8), b = *(const f32x4*)(wq + (size_t)row * 2048 + c * 8 + 4);
        const f32x4 e = *(const f32x4*)(ky + (size_t)row * 128 + c * 8), f = *(const f32x4*)(ky + (size_t)row * 128 + c * 8 + 4);
        const unsigned off = (c >> 3) * 16384 + t128_off(row, c & 7);
        *(LAS u32x4*)(lds + off) = (u32x4){pk2(a[0], a[1]), pk2(a[2], a[3]), pk2(b[0], b[1]), pk2(b[2], b[3])};
        *(LAS u32x4*)(lds + 32768 + off) = (u32x4){pk2(e[0], e[1]), pk2(e[2], e[3]), pk2(f[0], f[1]), pk2(f[2], f[3])};
    }
    __syncthreads();
    f32x16 acc[2];
#pragma unroll
    for (int i = 0; i < 2; ++i)
#pragma unroll
        for (int e = 0; e < 16; ++e) acc[i][e] = 0.f;
#pragma unroll
    for (int dh = 0; dh < 2; ++dh)
#pragma unroll
        for (int kk = 0; kk < 4; ++kk) {
            const bf16x8 b = ldsfrag(lds + 32768 + dh * 16384, t128_off(wt * 32 + r, 2 * kk + h));
#pragma unroll
            for (int i = 0; i < 2; ++i) acc[i] = MFMA32(ldsfrag(lds + dh * 16384, t128_off(wf * 64 + i * 32 + r, 2 * kk + h)), b, acc[i]);
        }
    bf16_t* dst = (bf16_t*)(p.ws + OFF_PWQ) + (size_t)l * 2048 * 1024 + (size_t)(g * 128 + wt * 32 + r) * 1024 + kt * 128 + wf * 64;
#pragma unroll
    for (int i = 0; i < 2; ++i)
#pragma unroll
        for (int g4 = 0; g4 < 4; ++g4)
            *(u32x2*)(dst + i * 32 + 8 * g4 + 4 * h) = (u32x2){pk2(acc[i][4 * g4], acc[i][4 * g4 + 1]), pk2(acc[i][4 * g4 + 2], acc[i][4 * g4 + 3])};
    __syncthreads();
}

DI void phase_prep(const Params& p, LAS uchar* lds) {
    const int tid = threadIdx.x;
    uchar* ws = p.ws;
    {
        const int nt0 = 16 * 36, nt1 = 16 * 16, nt2 = 16 * 31, nt3 = 16 * 16, nt4 = 4 * 12, nt5 = 2 * 16;
        const int total = nt0 + nt1 + nt2 + nt3 + nt4 + nt5;
        for (int t = blockIdx.x; t < total; t += gridDim.x) {
            int u = t;
            LAS float* sm = (LAS float*)lds;
            if (u < nt0) { conv_tile<GrpMap, true>(sm, p.e_w_in, 1024, 2304, (bf16_t*)(ws + OFF_WINE), (u % 16) * 64, (u / 16) * 64, nullptr, GrpMap()); continue; }
            u -= nt0;
            if (u < nt1) { conv_tile(sm, p.e_w_out, 1024, 1024, (bf16_t*)(ws + OFF_WOUTE), (u % 16) * 64, (u / 16) * 64, nullptr, IdMap()); continue; }
            u -= nt1;
            if (u < nt2) { conv_tile(sm, p.o_w_in, 1024, 1984, (bf16_t*)(ws + OFF_WINO), (u % 16) * 64, (u / 16) * 64, nullptr, OddMap()); continue; }
            u -= nt2;
            if (u < nt3) { conv_tile(sm, p.o_w_out, 1024, 1024, (bf16_t*)(ws + OFF_WOUTO), (u % 16) * 64, (u / 16) * 64, nullptr, IdMap()); continue; }
            u -= nt3;
            if (u < nt4) { conv_tile(sm, p.c_wq_up, 256, 768, (bf16_t*)(ws + OFF_WQUP), (u % 4) * 64, (u / 4) * 64, p.c_gq, IdMap()); continue; }
            u -= nt4;
            conv_tile(sm, p.c_wkv_up, 128, 1024, (bf16_t*)(ws + OFF_WKVUP), (u % 2) * 64, (u / 2) * 64, p.c_gkv, IdMap());
        }
        __syncthreads();
        for (int t = blockIdx.x; t < 256; t += gridDim.x) wsk_tile(p, lds, t);
    }
    const size_t gtid = (size_t)blockIdx.x * NTHR + tid, gsz = (size_t)gridDim.x * NTHR;
    for (size_t i = gtid; i < (size_t)64 * 1024 / 8; i += gsz) {
        const size_t hv = i / (32 * 1024 / 8), w = i % (32 * 1024 / 8);
        ((u32x4*)(ws + OFF_WINO + (size_t)(hv ? 2016 : 1888) * 1024 * 2))[w] = (u32x4){0u, 0u, 0u, 0u};
    }
    {
        const int kper = 1024 / KSPLIT;
        for (size_t t = gtid; t < (size_t)KSPLIT * 2 * 1536; t += gsz) {
            const int col4 = (int)(t % 1536), rem = (int)(t / 1536), layer = rem & 1, ks = rem >> 1;
            const float* W = p.w_mod + (size_t)layer * 1024 * 6144 + (size_t)(ks * kper) * 6144 + col4 * 4;
            f32x4 a0 = (f32x4){0.f, 0.f, 0.f, 0.f}, a1 = a0, a2 = a0;
#pragma unroll 8
            for (int kk = 0; kk < kper; ++kk) {
                const int k = ks * kper + kk;
                const f32x4 w = *(const f32x4*)(W + (size_t)kk * 6144);
                a0 += w * silu_f(p.c[k]); a1 += w * silu_f(p.c[1024 + k]); a2 += w * silu_f(p.c_ctx[k]);
            }
            float* mp = (float*)(ws + OFF_MODPART) + (size_t)(ks * 2 + layer) * 3 * 6144 + col4 * 4;
            *(f32x4*)(mp) = a0; *(f32x4*)(mp + 6144) = a1; *(f32x4*)(mp + 2 * 6144) = a2;
        }
    }
    for (size_t i = gtid; i < (size_t)8192 * 48; i += gsz) {
        const int pos = (int)(i / 48), j = (int)(i % 48);
        const float rr = (float)(pos / 64), cc = (float)(pos % 64);
        if (j < 32) {
            const int fi = j & 15;
            const float inv = 1.0f / powf(10000.0f, (float)(2 * fi) / 32.0f);
            const float ang = (j < 16 ? rr : cc) * inv;
            float s, c; sincosf(ang, &s, &c);
            ((f32x2*)(ws + OFF_ROPEAB))[(size_t)pos * 32 + j] = (f32x2){c, s};
        } else {
            const int jj = j - 32, fi = jj & 7;
            const float inv = 1.0f / powf(10000.0f, (float)(2 * fi) / 16.0f);
            const float ang = (jj < 8 ? rr : cc) * inv;
            float s, c; sincosf(ang, &s, &c);
            ((f32x2*)(ws + OFF_ROPEC))[(size_t)pos * 16 + jj] = (f32x2){c, s};
        }
    }
    if (gtid == 0) {
        float s1 = 0.f, s2 = 0.f;
        for (int i = 0; i < 64; ++i) { s1 += p.a_lq1[i] * p.a_lk1[i]; s2 += p.a_lq2[i] * p.a_lk2[i]; }
        ((float*)(ws + OFF_SCAL))[0] = expf(s1) - expf(s2) + 0.2f;
    }
}

DI void norm_row_store(const bf16_t* row, const float* g, const float* shift, const float* scale, bf16_t* dst, int lane, uchar* dst8 = nullptr) {
    f32x4 v[4]; float ss = 0.f;
#pragma unroll
    for (int j = 0; j < 4; ++j) { v[j] = ld4bf(row + 256 * j + 4 * lane); ss += v[j][0] * v[j][0] + v[j][1] * v[j][1] + v[j][2] * v[j][2] + v[j][3] * v[j][3]; }
    ss = wave_sum(ss);
    const float rstd = rsqrtf(ss * (1.0f / 1024.0f) + EPS);
#pragma unroll
    for (int j = 0; j < 4; ++j) {
        const int c0 = 256 * j + 4 * lane;
        const f32x4 gg = *(const f32x4*)(g + c0), sh = *(const f32x4*)(shift + c0), sc = *(const f32x4*)(scale + c0);
        const f32x4 y = v[j] * rstd * gg * (sc + 1.0f) + sh;
        u32x2 w; w.x = pk2(y[0], y[1]); w.y = pk2(y[2], y[3]);
        *(u32x2*)(dst + c0) = w;
        if (dst8) {
            int w8 = __builtin_amdgcn_cvt_pk_fp8_f32(y[0], y[1], 0, false);
            w8 = __builtin_amdgcn_cvt_pk_fp8_f32(y[2], y[3], w8, true);
            *(int*)(dst8 + c0) = w8;
        }
    }
}

DI void phase_norm1_l0(const Params& p, LAS uchar* lds) {
    const int tid = threadIdx.x, wave = __builtin_amdgcn_readfirstlane(tid >> 6), lane = tid & 63;
    LAS float* sm = (LAS float*)lds;
    const float* mpart = (const float*)(p.ws + OFF_MODPART);
    const int ntask = NT / 8, t0 = (int)((long)blockIdx.x * ntask / gridDim.x), t1 = (int)((long)(blockIdx.x + 1) * ntask / gridDim.x);
    int cur_mid = -1;
    for (int t = t0; t < t1; ++t) {
        const int tok0 = t * 8, mid = mod_id(tok0);
        if (mid != cur_mid) {
        cur_mid = mid;
        __syncthreads();
#pragma unroll
        for (int i = 0; i < 2048 / NTHR; ++i) {
            const int n = tid + i * NTHR;
            float part[KSPLIT];
#pragma unroll
            for (int ks = 0; ks < KSPLIT; ++ks) part[ks] = mpart[(size_t)((ks * 2 + 0) * 3 + mid) * 6144 + n];
            float s = p.b_mod[n];
#pragma unroll
            for (int ks = 0; ks < KSPLIT; ++ks) s += part[ks];
            sm[n] = s;
        }
        __syncthreads();
        }
        for (int rr = wave; rr < 8; rr += NW) {
            const int tok = tok0 + rr;
            const float* row = in_row(p, tok);
            f32x4 v[4]; float ss = 0.f;
#pragma unroll
            for (int j = 0; j < 4; ++j) { v[j] = *(const f32x4*)(row + 256 * j + 4 * lane); ss += v[j][0] * v[j][0] + v[j][1] * v[j][1] + v[j][2] * v[j][2] + v[j][3] * v[j][3]; }
            ss = wave_sum(ss);
            const float rstd = rsqrtf(ss * (1.0f / 1024.0f) + EPS);
            bf16_t* dst = (bf16_t*)(p.ws + OFF_HBF) + (size_t)tok * DM;
#pragma unroll
            for (int j = 0; j < 4; ++j) {
                const int c0 = 256 * j + 4 * lane;
                const f32x4 gg = *(const f32x4*)(p.norm1 + c0);
                f32x4 y;
#pragma unroll
                for (int e = 0; e < 4; ++e) y[e] = v[j][e] * rstd * gg[e] * (1.0f + sm[1024 + c0 + e]) + sm[c0 + e];
                int w8 = __builtin_amdgcn_cvt_pk_fp8_f32(y[0], y[1], 0, false);
                w8 = __builtin_amdgcn_cvt_pk_fp8_f32(y[2], y[3], w8, true);
                *(int*)((uchar*)(p.ws + OFF_HBF) + (size_t)tok * DM + c0) = w8;
            }
        }
    }
    float* mod = (float*)(p.ws + OFF_MOD);
    for (int e = blockIdx.x * NTHR + tid; e < 36864; e += gridDim.x * NTHR) {
        const int layer = e / 18432, rem = e % 18432, v = rem / 6144, n = rem % 6144;
        float part[KSPLIT];
#pragma unroll
        for (int ks = 0; ks < KSPLIT; ++ks) part[ks] = mpart[(size_t)((ks * 2 + layer) * 3 + v) * 6144 + n];
        float s = p.b_mod[layer * 6144 + n];
#pragma unroll
        for (int ks = 0; ks < KSPLIT; ++ks) s += part[ks];
        mod[e] = s;
    }
}

DI void phase_norm2(const Params& p, int layer, bool xonly) {
    const int tid = threadIdx.x, wave = __builtin_amdgcn_readfirstlane(tid >> 6), lane = tid & 63;
    if (layer == 0) {
        float* ssq64 = (float*)(p.ws + OFF_SSQ64);
        for (int i = blockIdx.x * NTHR + tid; i < NB * LCTX * 8; i += gridDim.x * NTHR) ssq64[(size_t)((i / (LCTX * 8)) * TPB) * 8 + (i % (LCTX * 8))] = 0.f;
    }
    const float* mod = (const float*)(p.ws + OFF_MOD);
    const int nrows = xonly ? NB * SEQ : NT;
    for (int rix = blockIdx.x * NW + wave; rix < nrows; rix += gridDim.x * NW) {
        const int tok = xonly ? (rix / SEQ) * TPB + LCTX + (rix % SEQ) : rix;
        const int mid = mod_id(tok);
        const float* mm = mod + (size_t)(layer * 3 + mid) * 6144;
        norm_row_store(resb_row(p, tok), p.norm2 + layer * DM, mm + 3 * 1024, mm + 4 * 1024, (bf16_t*)(p.ws + OFF_HBF) + (size_t)tok * DM, lane, p.ws + OFF_H8 + (size_t)tok * DM);
    }
}

struct EpiInEven {
    static constexpr bool PERM = false, AFTER_DRAIN = false;
    const Params* pp;
    DI void operator()(const f32x4 (&acc)[2][2][4][2], const pg8::Unit& u, int wr, int wc, int fr, int fq) const {
        const Params& p = *pp;
        const int fw = u.pn * 256 + wc * 64;
        const bool isv = (fw >= 1024 && fw < 1536) || fw >= 2176;
        const f32x4* ropeab = (const f32x4*)(p.ws + OFF_ROPEAB);
        const float qs = 0.125f * LOG2E;
        const int tok00 = u.pm * 256 + wr * 64 + fr;
        if (!isv) {
            const float* gain; size_t dbase; float osc = 1.f; int hs, hm;
            int g; bool isk = false;
            if (fw < 512) { g = fw >> 6; gain = p.a_qn; osc = qs; dbase = OFF_AQ; hs = 8; hm = ((g >> 1) * 2 + (g & 1)); }
            else if (fw < 1024) { g = (fw - 512) >> 6; gain = p.a_kn; dbase = OFF_AK; hs = 8; hm = ((g >> 1) * 2 + (g & 1)); isk = true; }
            else if (fw < 2048) { g = (fw - 1536) >> 6; gain = p.b_qn; osc = qs; dbase = OFF_BQ; hs = 8; hm = g; }
            else { g = (fw - 2048) >> 6; gain = p.b_kn; dbase = OFF_BK; hs = 2; hm = g; }
            f32x4 gg[2][2];
#pragma unroll
            for (int bj = 0; bj < 2; ++bj)
#pragma unroll
                for (int n = 0; n < 2; ++n) gg[bj][n] = *(const f32x4*)(gain + 32 * bj + 16 * n + 4 * fq) * osc;
            f32x4 cs[2][2], csn[2][2];
            {
                const int ti = tok00 % TPB; const int pos = max(ti - LCTX, 0);
#pragma unroll
                for (int bj = 0; bj < 2; ++bj)
#pragma unroll
                    for (int n = 0; n < 2; ++n) csn[bj][n] = ropeab[(size_t)pos * 16 + 8 * bj + 4 * n + fq];
            }
#pragma unroll
            for (int ai = 0; ai < 2; ++ai)
#pragma unroll
                for (int m = 0; m < 4; ++m) {
                    const int tok = tok00 + ai * 128 + m * 16;
                    const int b = tok / TPB, ti = tok - b * TPB;
                    const bool isx = ti >= LCTX;
#pragma unroll
                    for (int bj = 0; bj < 2; ++bj)
#pragma unroll
                        for (int n = 0; n < 2; ++n) cs[bj][n] = csn[bj][n];
                    if (ai * 4 + m < 7) {
                        const int tokn = tok00 + ((ai * 4 + m + 1) >> 2) * 128 + ((ai * 4 + m + 1) & 3) * 16;
                        const int posn = max(tokn % TPB - LCTX, 0);
#pragma unroll
                        for (int bj = 0; bj < 2; ++bj)
#pragma unroll
                            for (int n = 0; n < 2; ++n) csn[bj][n] = ropeab[(size_t)posn * 16 + 8 * bj + 4 * n + fq];
                    }
                    float ss = 0.f;
#pragma unroll
                    for (int bj = 0; bj < 2; ++bj)
#pragma unroll
                        for (int n = 0; n < 2; ++n)
#pragma unroll
                            for (int e = 0; e < 4; ++e) ss += acc[ai][bj][m][n][e] * acc[ai][bj][m][n][e];
                    ss += __shfl_xor(ss, 16); ss += __shfl_xor(ss, 32);
                    const float rstd = rsqrtf(ss * (1.0f / 64.0f) + EPS);
                    bf16_t* dst = (bf16_t*)(p.ws + dbase) + ((size_t)(b * hs + hm) * TPB + ti) * 64;
#pragma unroll
                    for (int bj = 0; bj < 2; ++bj)
#pragma unroll
                        for (int n = 0; n < 2; ++n) {
                            const int d = 32 * bj + 16 * n + 4 * fq;
                            float y0 = acc[ai][bj][m][n][0] * rstd * gg[bj][n][0], y1 = acc[ai][bj][m][n][1] * rstd * gg[bj][n][1];
                            float y2 = acc[ai][bj][m][n][2] * rstd * gg[bj][n][2], y3 = acc[ai][bj][m][n][3] * rstd * gg[bj][n][3];
                            if (isx) {
                                const f32x4 c4 = cs[bj][n];
                                const float z0 = y0 * c4[0] - y1 * c4[1], z1 = y0 * c4[1] + y1 * c4[0];
                                const float z2 = y2 * c4[2] - y3 * c4[3], z3 = y2 * c4[3] + y3 * c4[2];
                                y0 = z0; y1 = z1; y2 = z2; y3 = z3;
                            }
                            if (isk) {
                                int x8 = __builtin_amdgcn_cvt_pk_fp8_f32(y0, y1, 0, false); x8 = __builtin_amdgcn_cvt_pk_fp8_f32(y2, y3, x8, true);
                                *(int*)(p.ws + OFF_AK8 + ((size_t)(b * hs + hm) * TPB + ti) * 64 + d) = x8;
                            } else
                            *(u32x2*)(dst + d) = (u32x2){pk2(y0, y1), pk2(y2, y3)};
                        }
                }
        } else {
            const int lq = fr & 3;
#pragma unroll
            for (int ai = 0; ai < 2; ++ai)
#pragma unroll
                for (int m = 0; m < 4; ++m) {
                    const int tok = tok00 + ai * 128 + m * 16;
                    const int b = tok / TPB, ti = tok - b * TPB;
                    const int hd = (fw - 1024) >> 7, dvb = (fw - 1024) & 127;
                    const int k4 = (ti & 63) & ~3;
                    const int pos4 = 32 * ((k4 >> 2) & 1) + 16 * (k4 >> 5) + 4 * ((k4 >> 3) & 3);
                    uchar* dst = p.ws + OFF_AVT8 + (size_t)(b * 4 + hd) * 128 * TPB + (ti & ~63) + pos4;
#pragma unroll
                    for (int bj = 0; bj < 2; ++bj)
#pragma unroll
                        for (int n = 0; n < 2; ++n) {
                            float v0 = acc[ai][bj][m][n][0], v1 = acc[ai][bj][m][n][1], v2 = acc[ai][bj][m][n][2], v3 = acc[ai][bj][m][n][3];
                            {
                                const bool od = lq & 1;
                                const float s01 = od ? v0 : v1, s23 = od ? v2 : v3;
                                const float r01 = __int_as_float(__builtin_amdgcn_update_dpp(0, __float_as_int(s01), 0xB1, 0xF, 0xF, false));
                                const float r23 = __int_as_float(__builtin_amdgcn_update_dpp(0, __float_as_int(s23), 0xB1, 0xF, 0xF, false));
                                if (od) { v0 = r01; v2 = r23; } else { v1 = r01; v3 = r23; }
                            }
                            {
                                const bool up = lq & 2;
                                const float s02 = up ? v0 : v2, s13 = up ? v1 : v3;
                                const float r02 = __int_as_float(__builtin_amdgcn_update_dpp(0, __float_as_int(s02), 0x4E, 0xF, 0xF, false));
                                const float r13 = __int_as_float(__builtin_amdgcn_update_dpp(0, __float_as_int(s13), 0x4E, 0xF, 0xF, false));
                                if (up) { v0 = r02; v1 = r13; } else { v2 = r02; v3 = r13; }
                            }
                            int x8 = __builtin_amdgcn_cvt_pk_fp8_f32(v0, v1, 0, false); x8 = __builtin_amdgcn_cvt_pk_fp8_f32(v2, v3, x8, true);
                            *(int*)(dst + (size_t)(dvb + 32 * bj + 16 * n + 4 * fq + lq) * TPB) = x8;
                        }
                }
        }
    }
};
DI void inproj_even_tile(const Params& p, LAS uchar* lds, int ft, int tt) {
    const int tid = threadIdx.x, wave = __builtin_amdgcn_readfirstlane(tid >> 6), lane = tid & 63, r = lane & 31, h = lane >> 5, wf = wave >> 2, wt = wave & 3;
    const bf16_t* X = (const bf16_t*)(p.ws + OFF_HBF);
    const f32x4* ropeab = (const f32x4*)(p.ws + OFF_ROPEAB);
    f32x16 acc[2][2];
    gemm_block<2, 2, 3, RowGrp, true>(lds, (const bf16_t*)(p.ws + OFF_WINE), 512, X + (size_t)tt * 256 * 512, 512, 512, acc, RowGrp{ft * 128});
    const int fw = ft * 128 + wf * 64;
#pragma unroll
    for (int j = 0; j < 2; ++j) {
        const int tok = tt * 256 + wt * 64 + j * 32 + r;
        const int b = tok / TPB, ti = tok - b * TPB;
        const bool isx = ti >= LCTX; const int pos = ti - LCTX;
        const bool isv = (fw >= 1024 && fw < 1536) || fw >= 2176;
        if (!isv) {
            float ss = 0.f;
#pragma unroll
            for (int i = 0; i < 2; ++i)
#pragma unroll
                for (int e = 0; e < 16; ++e) ss += acc[i][j][e] * acc[i][j][e];
            ss += __shfl_xor(ss, 32);
            const float rstd = rsqrtf(ss * (1.0f / 64.0f) + EPS);
            const float* gain; bf16_t* dst; float osc = 1.f;
            const float qs = 0.125f * LOG2E;
            uchar* dst8 = nullptr;
            if (fw < 512) { const int g = fw >> 6; gain = p.a_qn; osc = qs; dst = (bf16_t*)(p.ws + OFF_AQ) + ((size_t)(b * 4 + (g >> 1)) * 2 + (g & 1)) * TPB * 64; }
            else if (fw < 1024) { const int g = (fw - 512) >> 6; gain = p.a_kn; dst = nullptr; dst8 = p.ws + OFF_AK8 + (((size_t)(b * 4 + (g >> 1)) * 2 + (g & 1)) * TPB + ti) * 64; }
            else if (fw < 2048) { const int g = (fw - 1536) >> 6; gain = p.b_qn; osc = qs; dst = (bf16_t*)(p.ws + OFF_BQ) + (size_t)(b * 8 + g) * TPB * 64; }
            else { const int g = (fw - 2048) >> 6; gain = p.b_kn; dst = nullptr; dst8 = p.ws + OFF_BK8 + ((size_t)(b * 2 + g) * TPB + ti) * 64; }
            dst += (size_t)ti * 64;
#pragma unroll
            for (int i = 0; i < 2; ++i)
#pragma unroll
                for (int g4 = 0; g4 < 4; ++g4) {
                    const int d = i * 32 + 8 * g4 + 4 * h;
                    const f32x4 gg = *(const f32x4*)(gain + d);
                    float y0 = acc[i][j][4 * g4 + 0] * rstd * gg[0], y1 = acc[i][j][4 * g4 + 1] * rstd * gg[1];
                    float y2 = acc[i][j][4 * g4 + 2] * rstd * gg[2], y3 = acc[i][j][4 * g4 + 3] * rstd * gg[3];
                    if (isx) {
                        const f32x4 cs = ropeab[((size_t)pos * 32 + (d >> 1)) >> 1];
                        const float z0 = y0 * cs[0] - y1 * cs[1], z1 = y0 * cs[1] + y1 * cs[0];
                        const float z2 = y2 * cs[2] - y3 * cs[3], z3 = y2 * cs[3] + y3 * cs[2];
                        y0 = z0; y1 = z1; y2 = z2; y3 = z3;
                    }
                    if (dst8) {
                        int x8 = __builtin_amdgcn_cvt_pk_fp8_f32(y0, y1, 0, false); x8 = __builtin_amdgcn_cvt_pk_fp8_f32(y2, y3, x8, true);
                        *(int*)(dst8 + d) = x8;
                    } else {
                        u32x2 w; w.x = pk2(y0 * osc, y1 * osc); w.y = pk2(y2 * osc, y3 * osc);
                        *(u32x2*)(dst + d) = w;
                    }
                }
        } else {
            const int tlc = wt * 64 + j * 32 + r, kk = tlc & 63;
            LAS uchar* bp = lds + (wf * 64 + 4 * h) * 256 + (tlc & ~63) + 32 * ((kk >> 2) & 1) + 16 * (kk >> 5) + 4 * ((kk >> 3) & 3) + (kk & 3);
#pragma unroll
            for (int i = 0; i < 2; ++i)
#pragma unroll
                for (int e = 0; e < 16; ++e) bp[(i * 32 + (e & 3) + 8 * (e >> 2)) * 256] = (uchar)__builtin_amdgcn_cvt_pk_fp8_f32(acc[i][j][e], acc[i][j][e], 0, false);
        }
    }
    if (ft * 128 >= 1024 && (ft * 128 < 1536 || ft * 128 >= 2176)) {
        __syncthreads();
        const int tok0 = tt * 256, b = tok0 / TPB, ti0 = tok0 - b * TPB;
        for (int idx = tid; idx < 128 * 16; idx += NTHR) {
            const int row = idx >> 4, pc = idx & 15;
            const int f = ft * 128 + row;
            uchar* dst;
            if (f < 1536) dst = p.ws + OFF_AVT8 + ((size_t)(b * 4 + ((f - 1024) >> 7)) * 128 + ((f - 1024) & 127)) * TPB;
            else dst = p.ws + OFF_BVT8 + ((size_t)(b * 2 + ((f - 2176) >> 6)) * 64 + ((f - 2176) & 63)) * TPB;
            *(u32x4*)(dst + ti0 + pc * 16) = *(const LAS u32x4*)(lds + row * 256 + pc * 16);
        }
        __syncthreads();
    }
}
DI void phase_inproj_even(const Params& p, LAS uchar* lds) {
    const pg8::Gemm g{(const bf16_t*)(p.ws + OFF_HBF), (const bf16_t*)(p.ws + OFF_WINE), NT, 2304, 512};
    const TileOrder S{8, 8 * NB * 32, true};
    const EpiInEven E{&p};
    pg8::gemm_phase<EpiInEven, TileOrder, true, true, true>(lds, g, S, E);
    for (int t = blockIdx.x; t < 164; t += gridDim.x) {
        int ft, tt;
        if (t < 132) { ft = 16 + (t & 1); tt = t >> 1; }
        else { const int u = t - 132; ft = u & 15; tt = (u >> 4) ? TPB / 256 : 0; }
        inproj_even_tile(p, lds, ft, tt);
    }
}

template <int NSUB, bool ROPE, int DVT, bool MASK>
DI void attn_core(LAS uchar* lds, const bf16_t* const (&qw)[NSUB], const bf16_t* qrw, const bf16_t* const (&kb)[NSUB], const bf16_t* krb,
                  const bf16_t* vtb, int ra0, int ra1, int rb0, int rb1, int qx, f32x16 (&O)[NSUB][DVT], float (&l)[NSUB]) {
    constexpr int KOFF_R = NSUB * 8192, VOFF = KOFF_R + (ROPE ? 4096 : 0), STG = VOFF + DVT * 4096;
    constexpr int NST = 4, NDMA = NSUB + (ROPE ? 1 : 0) + DVT / 2;
    const int tid = threadIdx.x, wave = __builtin_amdgcn_readfirstlane(tid >> 6), lane = tid & 63, r = lane & 31, h = lane >> 5;
    bf16x8 qf[NSUB][4]; bf16x8 qrf[2];
#pragma unroll
    for (int s = 0; s < NSUB; ++s)
#pragma unroll
        for (int kk = 0; kk < 4; ++kk) qf[s][kk] = *(const bf16x8*)(qw[s] + r * 64 + kk * 16 + h * 8);
    if (ROPE) {
#pragma unroll
        for (int kk = 0; kk < 2; ++kk) qrf[kk] = *(const bf16x8*)(qrw + r * 32 + kk * 16 + h * 8);
    }
#pragma unroll
    for (int s = 0; s < NSUB; ++s) {
        l[s] = 0.f;
#pragma unroll
        for (int d = 0; d < DVT; ++d)
#pragma unroll
            for (int e = 0; e < 16; ++e) O[s][d][e] = 0.f;
    }
    const int na = ra1 - ra0, ntile = na + (rb1 - rb0);
    auto issue = [&](int it, int stg) {
        const int kt64 = it < na ? ra0 + it : rb0 + (it - na);
        LAS uchar* st = lds + stg * STG;
#pragma unroll
        for (int s = 0; s < NSUB; ++s) dma_t128(st + s * 8192, (const uchar*)(kb[s] + (size_t)kt64 * 64 * 64), 128, 64, wave, lane);
        if (ROPE) dma_t64(st + KOFF_R, (const uchar*)(krb + (size_t)kt64 * 64 * 32), 64, wave, lane);
        dma_t128(st + VOFF, (const uchar*)(vtb + (size_t)kt64 * 64), (size_t)TPB * 2, DVT * 32, wave, lane);
    };
    WAIT_VM0();
    LDS_SYNC();
#pragma unroll
    for (int s0 = 0; s0 < NST - 1; ++s0) if (s0 < ntile) issue(s0, s0);
    int cs = 0, is = NST - 1;
    for (int it = 0; it < ntile; ++it) {
        if (it + NST - 2 < ntile) wait_vmcnt<(NST - 2) * NDMA>(); else wait_vmcnt<0>();
        RAW_BAR();
        if (it + NST - 1 < ntile) issue(it + NST - 1, is);
        const LAS uchar* st = lds + cs * STG;
        cs = cs + 1 == NST ? 0 : cs + 1; is = is + 1 == NST ? 0 : is + 1;
        const int kt64 = it < na ? ra0 + it : rb0 + (it - na);
        const bool domask = MASK && (it >= na);
#pragma unroll
        for (int kt = 0; kt < 2; ++kt) {
            bf16x8 pk[NSUB][2];
#pragma unroll
            for (int s = 0; s < NSUB; ++s) {
                f32x16 S;
#pragma unroll
                for (int e = 0; e < 16; ++e) S[e] = 0.f;
#pragma unroll
                for (int kk = 0; kk < 4; ++kk) S = MFMA32(ldsfrag(st + s * 8192, t128_off(kt * 32 + r, 2 * kk + h)), qf[s][kk], S);
                if (ROPE) {
#pragma unroll
                    for (int kk = 0; kk < 2; ++kk) S = MFMA32(ldsfrag(st + KOFF_R, t64_off(kt * 32 + r, 2 * kk + h)), qrf[kk], S);
                }
                float ls = 0.f;
#pragma unroll
                for (int s2 = 0; s2 < 2; ++s2) {
                    float pe[8];
#pragma unroll
                    for (int e = 0; e < 8; ++e) {
                        float pv = __builtin_amdgcn_exp2f(S[8 * s2 + e]);
                        if (MASK) {
                            if (domask) {
                                const int kx = kt64 * 64 + kt * 32 + crow(8 * s2 + e, h) - LCTX;
                                const int dd = kx - qx;
                                if (dd > 128 || dd < -128) pv = 0.f;
                            }
                        }
                        pe[e] = pv; ls += pv;
                    }
                    u32x4 w;
                    w.x = pk2(pe[0], pe[1]); w.y = pk2(pe[2], pe[3]); w.z = pk2(pe[4], pe[5]); w.w = pk2(pe[6], pe[7]);
                    pk[s][s2] = __builtin_bit_cast(bf16x8, w);
                }
                l[s] += ls;
            }
#pragma unroll
            for (int d = 0; d < DVT; ++d)
#pragma unroll
                for (int s2 = 0; s2 < 2; ++s2) {
                    const bf16x8 vf = ldsfrag(st + VOFF, t128_off(d * 32 + r, 2 * (2 * kt + s2) + h));
#pragma unroll
                    for (int s = 0; s < NSUB; ++s) O[s][d] = MFMA32(vf, pk[s][s2], O[s][d]);
                }
        }
    }
#pragma unroll
    for (int s = 0; s < NSUB; ++s) l[s] += __shfl_xor(l[s], 32);
}

template <bool ROPE, int DVT>
DI void attn_core_q2(LAS uchar* lds, const bf16_t* qw, const bf16_t* qrw, const bf16_t* kb, const bf16_t* krb, const bf16_t* vtb, int ntile,
                     f32x16 (&O)[2][DVT], float (&l)[2]) {
    constexpr int KOFF_R = 8192, VOFF = KOFF_R + (ROPE ? 4096 : 0), STG = VOFF + DVT * 4096;
    constexpr int NST = 4, NDMA = 1 + (ROPE ? 1 : 0) + DVT / 2;
    const int tid = threadIdx.x, wave = __builtin_amdgcn_readfirstlane(tid >> 6), lane = tid & 63, r = lane & 31, h = lane >> 5;
    bf16x8 qf[2][4]; bf16x8 qrf[2][2];
#pragma unroll
    for (int g = 0; g < 2; ++g) {
#pragma unroll
        for (int kk = 0; kk < 4; ++kk) qf[g][kk] = *(const bf16x8*)(qw + (g * 32 + r) * 64 + kk * 16 + h * 8);
        if (ROPE) {
#pragma unroll
            for (int kk = 0; kk < 2; ++kk) qrf[g][kk] = *(const bf16x8*)(qrw + (g * 32 + r) * 32 + kk * 16 + h * 8);
        }
        l[g] = 0.f;
#pragma unroll
        for (int d = 0; d < DVT; ++d)
#pragma unroll
            for (int e = 0; e < 16; ++e) O[g][d][e] = 0.f;
    }
    auto issue = [&](int it, int stg) {
        LAS uchar* st = lds + stg * STG;
        dma_t128(st, (const uchar*)(kb + (size_t)it * 64 * 64), 128, 64, wave, lane);
        if (ROPE) dma_t64(st + KOFF_R, (const uchar*)(krb + (size_t)it * 64 * 32), 64, wave, lane);
        dma_t128(st + VOFF, (const uchar*)(vtb + (size_t)it * 64), (size_t)TPB * 2, DVT * 32, wave, lane);
    };
    WAIT_VM0();
    LDS_SYNC();
#pragma unroll
    for (int s0 = 0; s0 < NST - 1; ++s0) if (s0 < ntile) issue(s0, s0);
    int cs = 0, is = NST - 1;
    for (int it = 0; it < ntile; ++it) {
        if (it + NST - 2 < ntile) wait_vmcnt<(NST - 2) * NDMA>(); else wait_vmcnt<0>();
        RAW_BAR();
        if (it + NST - 1 < ntile) issue(it + NST - 1, is);
        const LAS uchar* st = lds + cs * STG;
        cs = cs + 1 == NST ? 0 : cs + 1; is = is + 1 == NST ? 0 : is + 1;
#pragma unroll
        for (int kt = 0; kt < 2; ++kt) {
            f32x16 S[2];
#pragma unroll
            for (int g = 0; g < 2; ++g)
#pragma unroll
                for (int e = 0; e < 16; ++e) S[g][e] = 0.f;
#pragma unroll
            for (int kk = 0; kk < 4; ++kk) {
                const bf16x8 a = ldsfrag(st, t128_off(kt * 32 + r, 2 * kk + h));
#pragma unroll
                for (int g = 0; g < 2; ++g) S[g] = MFMA32(a, qf[g][kk], S[g]);
            }
            if (ROPE) {
#pragma unroll
                for (int kk = 0; kk < 2; ++kk) {
                    const bf16x8 a = ldsfrag(st + KOFF_R, t64_off(kt * 32 + r, 2 * kk + h));
#pragma unroll
                    for (int g = 0; g < 2; ++g) S[g] = MFMA32(a, qrf[g][kk], S[g]);
                }
            }
            bf16x8 pk[2][2];
#pragma unroll
            for (int g = 0; g < 2; ++g) {
                float ls = 0.f;
#pragma unroll
                for (int s2 = 0; s2 < 2; ++s2) {
                    float pe[8];
#pragma unroll
                    for (int e = 0; e < 8; ++e) { pe[e] = __builtin_amdgcn_exp2f(S[g][8 * s2 + e]); ls += pe[e]; }
                    u32x4 w;
                    w.x = pk2(pe[0], pe[1]); w.y = pk2(pe[2], pe[3]); w.z = pk2(pe[4], pe[5]); w.w = pk2(pe[6], pe[7]);
                    pk[g][s2] = __builtin_bit_cast(bf16x8, w);
                }
                l[g] += ls;
            }
#pragma unroll
            for (int d = 0; d < DVT; ++d)
#pragma unroll
                for (int s2 = 0; s2 < 2; ++s2) {
                    const bf16x8 vf = ldsfrag(st + VOFF, t128_off(d * 32 + r, 2 * (2 * kt + s2) + h));
#pragma unroll
                    for (int g = 0; g < 2; ++g) O[g][d] = MFMA32(vf, pk[g][s2], O[g][d]);
                }
        }
    }
#pragma unroll
    for (int g = 0; g < 2; ++g) l[g] += __shfl_xor(l[g], 32);
}

DI void conv_tables_dyn(const Params& p, LAS uchar* lds, int layer) {
    const int tid = threadIdx.x;
    volatile LAS unsigned* xst = (volatile LAS unsigned*)(lds + LDS_BYTES - 16);
    unsigned* ctr = (unsigned*)(p.ws + OFF_BAR) + 3584 + 64 * layer;
    constexpr unsigned n32 = 16384 * 1024 / 32, CH = 4096, NCH = 2 * n32 / CH;
    const float* pu = p.p_u + (size_t)layer * 16384 * 1024;
    const float* pv = p.p_v + (size_t)layer * 16384 * 1024;
    for (;;) {
        __syncthreads();
        if (tid == 0) xst[2] = __hip_atomic_fetch_add(ctr, 1u, __ATOMIC_RELAXED, __HIP_MEMORY_SCOPE_AGENT);
        __syncthreads();
        const unsigned c = xst[2];
        if (c >= NCH) break;
#pragma unroll 2
        for (unsigned q = 0; q < CH / NTHR; ++q) {
            const unsigned i = c * CH + q * NTHR + tid;
            const bool isu = i < n32; const unsigned j = isu ? i : i - n32;
            const f32x4* src = (const f32x4*)(isu ? pu : pv) + 8 * (size_t)j;
            const float sc = isu ? 64.0f : 2.0f;
            u32x4 w;
#pragma unroll
            for (int qq = 0; qq < 4; ++qq) {
                const f32x4 a = src[2 * qq], b = src[2 * qq + 1];
                unsigned d = 0;
                d = __builtin_amdgcn_cvt_scalef32_pk_fp4_f32(d, fminf(fmaxf(a[0] * sc, -6.f), 6.f), fminf(fmaxf(a[1] * sc, -6.f), 6.f), 1.0f, 0);
                d = __builtin_amdgcn_cvt_scalef32_pk_fp4_f32(d, fminf(fmaxf(a[2] * sc, -6.f), 6.f), fminf(fmaxf(a[3] * sc, -6.f), 6.f), 1.0f, 1);
                d = __builtin_amdgcn_cvt_scalef32_pk_fp4_f32(d, fminf(fmaxf(b[0] * sc, -6.f), 6.f), fminf(fmaxf(b[1] * sc, -6.f), 6.f), 1.0f, 2);
                d = __builtin_amdgcn_cvt_scalef32_pk_fp4_f32(d, fminf(fmaxf(b[2] * sc, -6.f), 6.f), fminf(fmaxf(b[3] * sc, -6.f), 6.f), 1.0f, 3);
                w[qq] = d;
            }
            ((u32x4*)(p.ws + (isu ? OFF_PU : OFF_PV) + (size_t)layer * 16384 * 512))[j] = w;
        }
    }
}

DI void phase_avt8(const Params& p) {
    auto conv_vt = [&](const bf16_t* src, uchar* dst, size_t nrow) {
        const size_t nchunk = nrow * TPB / 16;
        for (size_t i = (size_t)blockIdx.x * NTHR + threadIdx.x; i < nchunk; i += (size_t)gridDim.x * NTHR) {
            const size_t row = i / (TPB / 16); const int c = (int)(i % (TPB / 16));
            const int t64 = c >> 2, p0 = (c & 3) * 16;
            const bf16_t* srow = src + row * TPB + t64 * 64;
            unsigned w[4];
#pragma unroll
            for (int q = 0; q < 4; ++q) {
                float v[4];
#pragma unroll
                for (int e = 0; e < 4; ++e) {
                    const int pos = p0 + 4 * q + e, g = pos >> 5, j = pos & 31;
                    const int key = 32 * (j >> 4) + (j & 3) + 8 * ((j >> 2) & 3) + 4 * g;
                    v[e] = bf2f(srow[(key & ~15) | perm16(key & 15)]);
                }
                int x = __builtin_amdgcn_cvt_pk_fp8_f32(v[0], v[1], 0, false);
                x = __builtin_amdgcn_cvt_pk_fp8_f32(v[2], v[3], x, true);
                w[q] = (unsigned)x;
            }
            *(u32x4*)(dst + row * TPB + (size_t)c * 16) = (u32x4){w[0], w[1], w[2], w[3]};
        }
    };
    auto conv_k = [&](const u32x4* ks, u32x4* kd, size_t nk) {
        for (size_t i = (size_t)blockIdx.x * NTHR + threadIdx.x; i < nk; i += (size_t)gridDim.x * NTHR) {
            const u32x4 a = ks[2 * i], b = ks[2 * i + 1];
            u32x4 o;
            int x = __builtin_amdgcn_cvt_pk_fp8_f32(bflo(a.x), bfhi(a.x), 0, false); x = __builtin_amdgcn_cvt_pk_fp8_f32(bflo(a.y), bfhi(a.y), x, true); o.x = (unsigned)x;
            x = __builtin_amdgcn_cvt_pk_fp8_f32(bflo(a.z), bfhi(a.z), 0, false); x = __builtin_amdgcn_cvt_pk_fp8_f32(bflo(a.w), bfhi(a.w), x, true); o.y = (unsigned)x;
            x = __builtin_amdgcn_cvt_pk_fp8_f32(bflo(b.x), bfhi(b.x), 0, false); x = __builtin_amdgcn_cvt_pk_fp8_f32(bflo(b.y), bfhi(b.y), x, true); o.z = (unsigned)x;
            x = __builtin_amdgcn_cvt_pk_fp8_f32(bflo(b.z), bfhi(b.z), 0, false); x = __builtin_amdgcn_cvt_pk_fp8_f32(bflo(b.w), bfhi(b.w), x, true); o.w = (unsigned)x;
            kd[i] = o;
        }
    };
    conv_vt((const bf16_t*)(p.ws + OFF_AVT), p.ws + OFF_AVT8, (size_t)8 * 128);
    conv_vt((const bf16_t*)(p.ws + OFF_BVT), p.ws + OFF_BVT8, (size_t)4 * 64);
    conv_k((const u32x4*)(p.ws + OFF_AK), (u32x4*)(p.ws + OFF_AK8), (size_t)8 * 2 * TPB * 64 / 16);
    conv_k((const u32x4*)(p.ws + OFF_BK), (u32x4*)(p.ws + OFF_BK8), (size_t)4 * TPB * 64 / 16);
}
typedef short s16x2 __attribute__((ext_vector_type(2)));
DI void attn_core_a8(LAS uchar* lds, const bf16_t* qw, const uchar* kb8, const uchar* vt8, int ntile, f32x16 (&O)[4], float& l) {
    constexpr int VOFF = 4096, SUB = 12288, STG = 2 * SUB, NST = 4, NDMA = 6;
    const int tid = threadIdx.x, wave = __builtin_amdgcn_readfirstlane(tid >> 6), lane = tid & 63, r = lane & 31, h = lane >> 5;
    i32x8 qf8;
    {
        const u32x4* qp = (const u32x4*)(qw + r * 64 + h * 32);
#pragma unroll
        for (int c = 0; c < 4; ++c) {
            const u32x4 v = qp[c];
            s16x2 x = (s16x2){0, 0};
            x = __builtin_amdgcn_cvt_scalef32_pk_fp8_f32(x, bflo(v.x), bfhi(v.x), 0.125f, false); x = __builtin_amdgcn_cvt_scalef32_pk_fp8_f32(x, bflo(v.y), bfhi(v.y), 0.125f, true);
            qf8[2 * c] = __builtin_bit_cast(int, x);
            x = __builtin_amdgcn_cvt_scalef32_pk_fp8_f32(x, bflo(v.z), bfhi(v.z), 0.125f, false); x = __builtin_amdgcn_cvt_scalef32_pk_fp8_f32(x, bflo(v.w), bfhi(v.w), 0.125f, true);
            qf8[2 * c + 1] = __builtin_bit_cast(int, x);
        }
    }
    l = 0.f;
#pragma unroll
    for (int d = 0; d < 4; ++d)
#pragma unroll
        for (int e = 0; e < 16; ++e) O[d][e] = 0.f;
    ntile >>= 1;
    auto issue = [&](int it2, int stg) {
#pragma unroll
        for (int sb = 0; sb < 2; ++sb) {
            LAS uchar* st = lds + stg * STG + sb * SUB;
            const int it = 2 * it2 + sb;
            dma_t64(st, kb8 + (size_t)it * 64 * 64, 64, wave, lane);
            dma_t64(st + VOFF, vt8 + (size_t)it * 64, (size_t)TPB, wave, lane);
            dma_t64(st + VOFF + 4096, vt8 + (size_t)64 * TPB + (size_t)it * 64, (size_t)TPB, wave, lane);
        }
    };
    WAIT_VM0();
    LDS_SYNC();
#pragma unroll
    for (int s0 = 0; s0 < NST - 1; ++s0) if (s0 < ntile) issue(s0, s0);
    int cs = 0, is = NST - 1;
    for (int it = 0; it < ntile; ++it) {
        if (it + NST - 2 < ntile) wait_vmcnt<(NST - 2) * NDMA>(); else wait_vmcnt<0>();
        RAW_BAR();
        if (it + NST - 1 < ntile) issue(it + NST - 1, is);
        const LAS uchar* st0 = lds + cs * STG;
        cs = cs + 1 == NST ? 0 : cs + 1; is = is + 1 == NST ? 0 : is + 1;
#pragma unroll
        for (int sb = 0; sb < 2; ++sb) {
        const LAS uchar* st = st0 + sb * SUB;
        i32x8 pb;
        float ls = 0.f;
#pragma unroll
        for (int kt = 0; kt < 2; ++kt) {
            const u32x4 klo = *(const LAS u32x4*)(st + t64_off(kt * 32 + r, 2 * h)), khi = *(const LAS u32x4*)(st + t64_off(kt * 32 + r, 2 * h + 1));
            const i32x8 ka = (i32x8){(int)klo.x, (int)klo.y, (int)klo.z, (int)klo.w, (int)khi.x, (int)khi.y, (int)khi.z, (int)khi.w};
            f32x16 S;
#pragma unroll
            for (int e = 0; e < 16; ++e) S[e] = 0.f;
            S = __builtin_amdgcn_mfma_scale_f32_32x32x64_f8f6f4(ka, qf8, S, 0, 0, 0, 0x7f7f7f7f, 0, 0x7c7c7c7c);
#pragma unroll
            for (int w = 0; w < 4; ++w) {
                const float p0 = __builtin_amdgcn_exp2f(S[4 * w]), p1 = __builtin_amdgcn_exp2f(S[4 * w + 1]);
                const float p2 = __builtin_amdgcn_exp2f(S[4 * w + 2]), p3 = __builtin_amdgcn_exp2f(S[4 * w + 3]);
                ls += (p0 + p1) + (p2 + p3);
                s16x2 x = (s16x2){0, 0};
                x = __builtin_amdgcn_cvt_scalef32_pk_fp8_f32(x, p0, p1, 32.0f, false);
                x = __builtin_amdgcn_cvt_scalef32_pk_fp8_f32(x, p2, p3, 32.0f, true);
                pb[4 * kt + w] = __builtin_bit_cast(int, x);
            }
        }
        l += ls;
#pragma unroll
        for (int d = 0; d < 4; ++d) {
            const u32x4 lo = *(const LAS u32x4*)(st + VOFF + t64_off(d * 32 + r, 2 * h)), hi = *(const LAS u32x4*)(st + VOFF + t64_off(d * 32 + r, 2 * h + 1));
            const i32x8 va = (i32x8){(int)lo.x, (int)lo.y, (int)lo.z, (int)lo.w, (int)hi.x, (int)hi.y, (int)hi.z, (int)hi.w};
            O[d] = __builtin_amdgcn_mfma_scale_f32_32x32x64_f8f6f4(va, pb, O[d], 0, 0, 0, 0x7f7f7f7f, 0, 0x84848484);
        }
        }
    }
    l += __shfl_xor(l, 32);
}

DI void attn_core_b8(LAS uchar* lds, const bf16_t* qw, const uchar* kb8, const uchar* vt8, int na, int rb0, int rb1, int qx, f32x16 (&O)[2], float& l) {
    constexpr int VOFF = 4096, STG = 8192, NST = 4, NDMA = 2;
    const int tid = threadIdx.x, wave = __builtin_amdgcn_readfirstlane(tid >> 6), lane = tid & 63, r = lane & 31, h = lane >> 5;
    const int ntile = na + (rb1 - rb0);
    i32x8 qf8;
    {
        const u32x4* qp = (const u32x4*)(qw + r * 64 + h * 32);
#pragma unroll
        for (int c = 0; c < 4; ++c) {
            const u32x4 v = qp[c];
            s16x2 x = (s16x2){0, 0};
            x = __builtin_amdgcn_cvt_scalef32_pk_fp8_f32(x, bflo(v.x), bfhi(v.x), 0.125f, false); x = __builtin_amdgcn_cvt_scalef32_pk_fp8_f32(x, bflo(v.y), bfhi(v.y), 0.125f, true);
            qf8[2 * c] = __builtin_bit_cast(int, x);
            x = __builtin_amdgcn_cvt_scalef32_pk_fp8_f32(x, bflo(v.z), bfhi(v.z), 0.125f, false); x = __builtin_amdgcn_cvt_scalef32_pk_fp8_f32(x, bflo(v.w), bfhi(v.w), 0.125f, true);
            qf8[2 * c + 1] = __builtin_bit_cast(int, x);
        }
    }
    l = 0.f;
#pragma unroll
    for (int d = 0; d < 2; ++d)
#pragma unroll
        for (int e = 0; e < 16; ++e) O[d][e] = 0.f;
    auto issue = [&](int it, int stg) {
        const int kt64 = it < na ? it : rb0 + (it - na);
        LAS uchar* st = lds + stg * STG;
        dma_t64(st, kb8 + (size_t)kt64 * 64 * 64, 64, wave, lane);
        dma_t64(st + VOFF, vt8 + (size_t)kt64 * 64, (size_t)TPB, wave, lane);
    };
    WAIT_VM0();
    LDS_SYNC();
#pragma unroll
    for (int s0 = 0; s0 < NST - 1; ++s0) if (s0 < ntile) issue(s0, s0);
    int cs = 0, is = NST - 1;
    for (int it = 0; it < ntile; ++it) {
        if (it + NST - 2 < ntile) wait_vmcnt<(NST - 2) * NDMA>(); else wait_vmcnt<0>();
        RAW_BAR();
        if (it + NST - 1 < ntile) issue(it + NST - 1, is);
        const LAS uchar* st = lds + cs * STG;
        cs = cs + 1 == NST ? 0 : cs + 1; is = is + 1 == NST ? 0 : is + 1;
        const bool domask = it >= na;
        const int key0 = (rb0 + (it - na)) * 64 - LCTX;
        i32x8 pb;
        float ls = 0.f;
#pragma unroll
        for (int kt = 0; kt < 2; ++kt) {
            const u32x4 klo = *(const LAS u32x4*)(st + t64_off(kt * 32 + r, 2 * h)), khi = *(const LAS u32x4*)(st + t64_off(kt * 32 + r, 2 * h + 1));
            const i32x8 ka = (i32x8){(int)klo.x, (int)klo.y, (int)klo.z, (int)klo.w, (int)khi.x, (int)khi.y, (int)khi.z, (int)khi.w};
            f32x16 S;
#pragma unroll
            for (int e = 0; e < 16; ++e) S[e] = 0.f;
            S = __builtin_amdgcn_mfma_scale_f32_32x32x64_f8f6f4(ka, qf8, S, 0, 0, 0, 0x7f7f7f7f, 0, 0x7c7c7c7c);
#pragma unroll
            for (int w = 0; w < 4; ++w) {
                float pv[4];
#pragma unroll
                for (int e = 0; e < 4; ++e) {
                    pv[e] = __builtin_amdgcn_exp2f(S[4 * w + e]);
                    if (domask) {
                        const int dd = key0 + kt * 32 + crow(4 * w + e, h) - qx;
                        if (dd > 128 || dd < -128) pv[e] = 0.f;
                    }
                }
                ls += (pv[0] + pv[1]) + (pv[2] + pv[3]);
                s16x2 x = (s16x2){0, 0};
                x = __builtin_amdgcn_cvt_scalef32_pk_fp8_f32(x, pv[0], pv[1], 32.0f, false);
                x = __builtin_amdgcn_cvt_scalef32_pk_fp8_f32(x, pv[2], pv[3], 32.0f, true);
                pb[4 * kt + w] = __builtin_bit_cast(int, x);
            }
        }
        l += ls;
#pragma unroll
        for (int d = 0; d < 2; ++d) {
            const u32x4 lo = *(const LAS u32x4*)(st + VOFF + t64_off(d * 32 + r, 2 * h)), hi = *(const LAS u32x4*)(st + VOFF + t64_off(d * 32 + r, 2 * h + 1));
            const i32x8 va = (i32x8){(int)lo.x, (int)lo.y, (int)lo.z, (int)lo.w, (int)hi.x, (int)hi.y, (int)hi.z, (int)hi.w};
            O[d] = __builtin_amdgcn_mfma_scale_f32_32x32x64_f8f6f4(va, pb, O[d], 0, 0, 0, 0x7f7f7f7f, 0, 0x84848484);
        }
    }
    l += __shfl_xor(l, 32);
}

template <bool ROPE>
DI void attn_core_q2f8(LAS uchar* lds, const bf16_t* qw, const bf16_t* qrw, const uchar* kb8, const bf16_t* krb, const uchar* vt8, int ntile,
                       f32x16 (&O)[2][2], float (&l)[2]) {
    constexpr int KOFF_R = 4096, VOFF = KOFF_R + (ROPE ? 4096 : 0), STG = VOFF + 4096;
    constexpr int NST = 4, NDMA = 1 + (ROPE ? 1 : 0) + 1;
    const int tid = threadIdx.x, wave = __builtin_amdgcn_readfirstlane(tid >> 6), lane = tid & 63, r = lane & 31, h = lane >> 5;
    i32x8 qf8[2]; bf16x8 qrf[2][2];
#pragma unroll
    for (int g = 0; g < 2; ++g) {
        {
            const u32x4* qp = (const u32x4*)(qw + (g * 32 + r) * 64 + h * 32);
#pragma unroll
            for (int c = 0; c < 4; ++c) {
                const u32x4 v = qp[c];
                s16x2 x = (s16x2){0, 0};
                x = __builtin_amdgcn_cvt_scalef32_pk_fp8_f32(x, bflo(v.x), bfhi(v.x), 0.125f, false); x = __builtin_amdgcn_cvt_scalef32_pk_fp8_f32(x, bflo(v.y), bfhi(v.y), 0.125f, true);
                qf8[g][2 * c] = __builtin_bit_cast(int, x);
                x = __builtin_amdgcn_cvt_scalef32_pk_fp8_f32(x, bflo(v.z), bfhi(v.z), 0.125f, false); x = __builtin_amdgcn_cvt_scalef32_pk_fp8_f32(x, bflo(v.w), bfhi(v.w), 0.125f, true);
                qf8[g][2 * c + 1] = __builtin_bit_cast(int, x);
            }
        }
        if (ROPE) {
#pragma unroll
            for (int kk = 0; kk < 2; ++kk) qrf[g][kk] = *(const bf16x8*)(qrw + (g * 32 + r) * 32 + kk * 16 + h * 8);
        }
        l[g] = 0.f;
#pragma unroll
        for (int d = 0; d < 2; ++d)
#pragma unroll
            for (int e = 0; e < 16; ++e) O[g][d][e] = 0.f;
    }
    auto issue = [&](int it, int stg) {
        LAS uchar* st = lds + stg * STG;
        dma_t64(st, kb8 + (size_t)it * 64 * 64, 64, wave, lane);
        if (ROPE) dma_t64(st + KOFF_R, (const uchar*)(krb + (size_t)it * 64 * 32), 64, wave, lane);
        dma_t64(st + VOFF, vt8 + (size_t)it * 64, (size_t)TPB, wave, lane);
    };
    WAIT_VM0();
    LDS_SYNC();
#pragma unroll
    for (int s0 = 0; s0 < NST - 1; ++s0) if (s0 < ntile) issue(s0, s0);
    int cs = 0, is = NST - 1;
    for (int it = 0; it < ntile; ++it) {
        if (it + NST - 2 < ntile) wait_vmcnt<(NST - 2) * NDMA>(); else wait_vmcnt<0>();
        RAW_BAR();
        if (it + NST - 1 < ntile) issue(it + NST - 1, is);
        const LAS uchar* st = lds + cs * STG;
        cs = cs + 1 == NST ? 0 : cs + 1; is = is + 1 == NST ? 0 : is + 1;
        i32x8 pb[2];
#pragma unroll
        for (int kt = 0; kt < 2; ++kt) {
            f32x16 S[2];
#pragma unroll
            for (int g = 0; g < 2; ++g)
#pragma unroll
                for (int e = 0; e < 16; ++e) S[g][e] = 0.f;
            {
                const u32x4 klo = *(const LAS u32x4*)(st + t64_off(kt * 32 + r, 2 * h)), khi = *(const LAS u32x4*)(st + t64_off(kt * 32 + r, 2 * h + 1));
                const i32x8 ka = (i32x8){(int)klo.x, (int)klo.y, (int)klo.z, (int)klo.w, (int)khi.x, (int)khi.y, (int)khi.z, (int)khi.w};
#pragma unroll
                for (int g = 0; g < 2; ++g) S[g] = __builtin_amdgcn_mfma_scale_f32_32x32x64_f8f6f4(ka, qf8[g], S[g], 0, 0, 0, 0x7f7f7f7f, 0, 0x7c7c7c7c);
            }
            if (ROPE) {
#pragma unroll
                for (int kk = 0; kk < 2; ++kk) {
                    const bf16x8 a = ldsfrag(st + KOFF_R, t64_off(kt * 32 + r, 2 * kk + h));
#pragma unroll
                    for (int g = 0; g < 2; ++g) S[g] = MFMA32(a, qrf[g][kk], S[g]);
                }
            }
#pragma unroll
            for (int g = 0; g < 2; ++g) {
                float ls = 0.f;
#pragma unroll
                for (int w = 0; w < 4; ++w) {
                    const float p0 = __builtin_amdgcn_exp2f(S[g][4 * w]), p1 = __builtin_amdgcn_exp2f(S[g][4 * w + 1]);
                    const float p2 = __builtin_amdgcn_exp2f(S[g][4 * w + 2]), p3 = __builtin_amdgcn_exp2f(S[g][4 * w + 3]);
                    ls += (p0 + p1) + (p2 + p3);
                    s16x2 x = (s16x2){0, 0};
                    x = __builtin_amdgcn_cvt_scalef32_pk_fp8_f32(x, p0, p1, 32.0f, false);
                    x = __builtin_amdgcn_cvt_scalef32_pk_fp8_f32(x, p2, p3, 32.0f, true);
                    pb[g][4 * kt + w] = __builtin_bit_cast(int, x);
                }
                l[g] += ls;
            }
            __builtin_amdgcn_sched_barrier(0);
        }
#pragma unroll
        for (int d = 0; d < 2; ++d) {
            const u32x4 lo = *(const LAS u32x4*)(st + VOFF + t64_off(d * 32 + r, 2 * h)), hi = *(const LAS u32x4*)(st + VOFF + t64_off(d * 32 + r, 2 * h + 1));
            const i32x8 va = (i32x8){(int)lo.x, (int)lo.y, (int)lo.z, (int)lo.w, (int)hi.x, (int)hi.y, (int)hi.z, (int)hi.w};
#pragma unroll
            for (int g = 0; g < 2; ++g) O[g][d] = __builtin_amdgcn_mfma_scale_f32_32x32x64_f8f6f4(va, pb[g], O[g][d], 0, 0, 0, 0x7f7f7f7f, 0, 0x84848484);
        }
    }
#pragma unroll
    for (int g = 0; g < 2; ++g) l[g] += __shfl_xor(l[g], 32);
}

DI void phase_attn_l0(const Params& p, LAS uchar* lds) {
    const int tid = threadIdx.x, wave = __builtin_amdgcn_readfirstlane(tid >> 6), lane = tid & 63, r = lane & 31, h = lane >> 5;
    const float lam = ((const float*)(p.ws + OFF_SCAL))[0];
    bf16_t* aout = (bf16_t*)(p.ws + OFF_AOUT);
    const int xcd = blockIdx.x & 7, lb = blockIdx.x >> 3, nlb = gridDim.x >> 3;
    const int nA = (32 - lb + nlb - 1) / nlb, nB = (64 - lb + nlb - 1) / nlb, nAc = lb < 1 ? 1 : 0, nBc = lb < 2 ? 1 : 0;
    for (int it = 0; it < nA + nB + nAc + nBc; ++it) {
        if (it < nA || (it >= nA + nB && it < nA + nB + nAc)) {
            const int b = xcd >> 2, hd = xcd & 3; int q0, ra1;
            if (it < nA) { q0 = LCTX + (lb + it * nlb) * 256; ra1 = NCHUNK; }
            else { q0 = 0; ra1 = LCTX / 64; }
            const bf16_t* qb = (const bf16_t*)(p.ws + OFF_AQ) + (size_t)(b * 4 + hd) * 2 * TPB * 64;
            const bf16_t* kbp = (const bf16_t*)(p.ws + OFF_AK) + (size_t)(b * 4 + hd) * 2 * TPB * 64;
            const uchar* vt8 = p.ws + OFF_AVT8 + (size_t)(b * 4 + hd) * 128 * TPB;
            const uchar* kb8 = p.ws + OFF_AK8 + (size_t)(b * 4 + hd) * 2 * TPB * 64;
            f32x16 O[1][4]; float l[1];
            const int tok = b * TPB + q0 + wave * 32 + r;
            bf16_t* dst = aout + (size_t)tok * DM + hd * 128;
            {
                attn_core_a8(lds, qb + (size_t)(q0 + wave * 32) * 64, kb8, vt8, ra1, O[0], l[0]);
                const float i0 = 1.0f / l[0];
#pragma unroll
                for (int d = 0; d < 4; ++d)
#pragma unroll
                    for (int g4 = 0; g4 < 4; ++g4)
                        *(u32x2*)(dst + d * 32 + 8 * g4 + 4 * h) = (u32x2){pk2(O[0][d][4 * g4] * i0, O[0][d][4 * g4 + 1] * i0), pk2(O[0][d][4 * g4 + 2] * i0, O[0][d][4 * g4 + 3] * i0)};
            }
            {
                attn_core_a8(lds, qb + (size_t)TPB * 64 + (size_t)(q0 + wave * 32) * 64, kb8 + (size_t)TPB * 64, vt8, ra1, O[0], l[0]);
            }
            const float i1 = lam / l[0];
            float ss = 0.f;
#pragma unroll
            for (int d = 0; d < 4; ++d)
#pragma unroll
                for (int g4 = 0; g4 < 4; ++g4) {
                    const u32x2 o1 = __builtin_nontemporal_load((const u32x2*)(dst + d * 32 + 8 * g4 + 4 * h));
                    const float a0 = bflo(o1.x) - O[0][d][4 * g4] * i1, a1 = bfhi(o1.x) - O[0][d][4 * g4 + 1] * i1;
                    const float a2 = bflo(o1.y) - O[0][d][4 * g4 + 2] * i1, a3 = bfhi(o1.y) - O[0][d][4 * g4 + 3] * i1;
                    O[0][d][4 * g4] = a0; O[0][d][4 * g4 + 1] = a1; O[0][d][4 * g4 + 2] = a2; O[0][d][4 * g4 + 3] = a3;
                    ss += a0 * a0 + a1 * a1 + a2 * a2 + a3 * a3;
                }
            ss += __shfl_xor(ss, 32);
            const float rstd = rsqrtf(ss * (1.0f / 128.0f) + EPS) * 0.8f;
#pragma unroll
            for (int d = 0; d < 4; ++d)
#pragma unroll
                for (int g4 = 0; g4 < 4; ++g4) {
                    const int dv = d * 32 + 8 * g4 + 4 * h;
                    const f32x4 gg = *(const f32x4*)(p.a_gn + dv);
                    u32x2 w; w.x = pk2(O[0][d][4 * g4] * rstd * gg[0], O[0][d][4 * g4 + 1] * rstd * gg[1]);
                    w.y = pk2(O[0][d][4 * g4 + 2] * rstd * gg[2], O[0][d][4 * g4 + 3] * rstd * gg[3]);
                    *(u32x2*)(dst + dv) = w;
                }
        } else {
#ifndef NO_B_UNIT
            const int b = xcd >> 2, kvh = (xcd >> 1) & 1; int q0, rb0, rb1;
            if (it < nA + nB) {
                const int qx0 = ((xcd & 1) * 64 + lb + (it - nA) * nlb) * 64; q0 = LCTX + qx0;
                const int lo = qx0 - 128 < 0 ? 0 : qx0 - 128, hi = qx0 + 191 > SEQ - 1 ? SEQ - 1 : qx0 + 191;
                rb0 = lo / 64 + 4; rb1 = hi / 64 + 5;
            } else { q0 = ((xcd & 1) * 2 + lb) * 64; rb0 = 0; rb1 = 0; }
            q0 += (wave >> 2) * 32;
            const int hq = kvh * 4 + (wave & 3);
            const bf16_t* qw = (const bf16_t*)(p.ws + OFF_BQ) + (size_t)(b * 8 + hq) * TPB * 64 + (size_t)q0 * 64;
            const uchar* kb8 = p.ws + OFF_BK8 + (size_t)(b * 2 + kvh) * TPB * 64;
            const uchar* vt8 = p.ws + OFF_BVT8 + (size_t)(b * 2 + kvh) * 64 * TPB;
            f32x16 O[1][2]; float l[1];
            attn_core_b8(lds, qw, kb8, vt8, LCTX / 64, rb0, rb1, q0 - LCTX + r, O[0], l[0]);
            const float inv = 1.0f / (l[0] + __builtin_amdgcn_exp2f(p.b_sink[hq] * LOG2E));
            const int tok = b * TPB + q0 + r;
            bf16_t* dst = aout + (size_t)tok * DM + 512 + hq * 64;
#pragma unroll
            for (int d = 0; d < 2; ++d)
#pragma unroll
                for (int g4 = 0; g4 < 4; ++g4) {
                    const int dv = d * 32 + 8 * g4 + 4 * h;
                    u32x2 w; w.x = pk2(O[0][d][4 * g4] * inv, O[0][d][4 * g4 + 1] * inv); w.y = pk2(O[0][d][4 * g4 + 2] * inv, O[0][d][4 * g4 + 3] * inv);
                    *(u32x2*)(dst + dv) = w;
                }
#endif
        }
    }
}

DI void phase_outproj_ctx(const Params& p, LAS uchar* lds, int layer, size_t woff);
struct EpiOutProj {
    static constexpr bool PERM = false, AFTER_DRAIN = false;
    const Params* pp; int layer;
    DI void operator()(const f32x4 (&acc)[2][2][4][2], const pg8::Unit& u, int wr, int wc, int fr, int fq) const {
        const Params& p = *pp;
        const float* mod = (const float*)(p.ws + OFF_MOD);
        const int col0 = u.pn * 256 + wc * 32 + 4 * fq;
#pragma unroll
        for (int ai = 0; ai < 2; ++ai)
#pragma unroll
            for (int m = 0; m < 4; ++m) {
                const int tok = u.pm * 256 + ai * 128 + wr * 64 + m * 16 + fr;
                const int mid = mod_id(tok);
                const float* gate = mod + (size_t)(layer * 3 + mid) * 6144 + 2 * 1024 + col0;
                const float* rin = in_row(p, tok) + col0;
                bf16_t* rb = resb_row(p, tok) + col0;
#pragma unroll
                for (int bj = 0; bj < 2; ++bj)
#pragma unroll
                    for (int n = 0; n < 2; ++n) {
                        const int o = bj * 128 + n * 16;
                        const f32x4 gg = *(const f32x4*)(gate + o), xi = layer == 0 ? *(const f32x4*)(rin + o) : ld4bf(rb + o);
                        st4bf(rb + o, xi + gg * acc[ai][bj][m][n]);
                    }
            }
    }
};
DI void phase_outproj(const Params& p, LAS uchar* lds, int layer, size_t woff, bool xonly) {
    const pg8::Gemm g{(const bf16_t*)(p.ws + OFF_AOUT), (const bf16_t*)(p.ws + woff), NT, 1024, 1024};
    const TileOrder S{4, 4 * NB * 32, true};
    const EpiOutProj E{&p, layer};
    pg8::gemm_phase<EpiOutProj, TileOrder, true, true>(lds, g, S, E);
    if (!xonly) phase_outproj_ctx(p, lds, layer, woff);
}

DI void phase_outproj_ctx(const Params& p, LAS uchar* lds, int layer, size_t woff) {
    const int tid = threadIdx.x, wave = __builtin_amdgcn_readfirstlane(tid >> 6), lane = tid & 63, r = lane & 31, h = lane >> 5, wf = wave >> 2, wt = wave & 3;
    const bf16_t* Wt = (const bf16_t*)(p.ws + woff);
    const bf16_t* X = (const bf16_t*)(p.ws + OFF_AOUT);
    const float* mod = (const float*)(p.ws + OFF_MOD);
    const int nF = 16;
    for (int t = blockIdx.x; t < nF * NB * 2; t += gridDim.x) {
        const int ft = t % nF, rest = t / nF, tok0 = (rest >> 1) * TPB + (rest & 1) * 128;
        f32x16 acc[1][1];
        gemm_block<1, 1, 3>(lds, Wt + (size_t)ft * 64 * 1024, 1024, X + (size_t)tok0 * 1024, 1024, 1024, acc);
#pragma unroll
        for (int j = 0; j < 1; ++j) {
            const int tok = tok0 + wt * 32 + r;
            const int mid = mod_id(tok);
            const float* gate = mod + (size_t)(layer * 3 + mid) * 6144 + 2 * 1024;
            const float* rin = in_row(p, tok);
            bf16_t* rb = resb_row(p, tok);
#pragma unroll
            for (int g4 = 0; g4 < 4; ++g4) {
                const int f = ft * 64 + wf * 32 + 8 * g4 + 4 * h;
                const f32x4 gg = *(const f32x4*)(gate + f), xi = layer == 0 ? *(const f32x4*)(rin + f) : ld4bf(rb + f);
                f32x4 o;
#pragma unroll
                for (int e = 0; e < 4; ++e) o[e] = xi[e] + gg[e] * acc[0][j][4 * g4 + e];
                st4bf(rb + f, o);
            }
        }
    }
}

struct EpiPQ {
    static constexpr bool PERM = true, AFTER_DRAIN = false;
    bf16_t* O;
    DI void operator()(const f32x4 (&acc)[2][2][4][2], const pg8::Unit& u, int wr, int wc, int fr, int fq) const {
        const int col0 = u.pn * 256 + wc * 32 + 8 * fq;
#pragma unroll
        for (int ai = 0; ai < 2; ++ai)
#pragma unroll
            for (int m = 0; m < 4; ++m) {
                bf16_t* rowp = O + (size_t)(u.pm * 256 + ai * 128 + wr * 64 + m * 16 + fr) * 2048 + col0;
#pragma unroll
                for (int bj = 0; bj < 2; ++bj) {
                    const f32x4 v0 = acc[ai][bj][m][0], v1 = acc[ai][bj][m][1];
                    *(u32x4*)(rowp + bj * 128) = (u32x4){pk2(v0[0], v0[1]), pk2(v0[2], v0[3]), pk2(v1[0], v1[1]), pk2(v1[2], v1[3])};
                }
            }
    }
};
DI void phase_peer_pq_ctx(const Params& p, LAS uchar* lds, int layer) {
    const int tid = threadIdx.x, wave = __builtin_amdgcn_readfirstlane(tid >> 6), lane = tid & 63, r = lane & 31, h = lane >> 5, wf = wave >> 2, wt = wave & 3;
    const bf16_t* Wt = (const bf16_t*)(p.ws + OFF_PWQ) + (size_t)layer * 2048 * 1024;
    const bf16_t* X = (const bf16_t*)(p.ws + OFF_HBF);
    bf16_t* scores = (bf16_t*)(p.ws + OFF_SCORES);
    const int nF = 32;
    for (int t = blockIdx.x; t < nF * NB * 2; t += gridDim.x) {
        const int ft = t % nF, rest = t / nF, tok0 = (rest >> 1) * TPB + (rest & 1) * 128;
        f32x16 sc[1][1];
        gemm_block<1, 1, 3>(lds, Wt + (size_t)ft * 64 * 1024, 1024, X + (size_t)tok0 * 1024, 1024, 1024, sc);
        {
            const int tok = tok0 + wt * 32 + r;
            bf16_t* dst = scores + (size_t)tok * 2048 + ft * 64 + wf * 32;
#pragma unroll
            for (int g4 = 0; g4 < 4; ++g4)
                *(u32x2*)(dst + 8 * g4 + 4 * h) = (u32x2){pk2(sc[0][0][4 * g4], sc[0][0][4 * g4 + 1]), pk2(sc[0][0][4 * g4 + 2], sc[0][0][4 * g4 + 3])};
        }
    }
}
DI void phase_peer_pq(const Params& p, LAS uchar* lds, int layer, bool xonly) {
    const pg8::Gemm g{(const bf16_t*)(p.ws + OFF_HBF), (const bf16_t*)(p.ws + OFF_PWQ) + (size_t)layer * 2048 * 1024, NT, 2048, 1024};
    const TileOrder S{8, 8 * NB * 32, true};
    const EpiPQ E{(bf16_t*)(p.ws + OFF_SCORES)};
    pg8::gemm_phase<EpiPQ, TileOrder, true, true>(lds, g, S, E);
    if (!xonly) phase_peer_pq_ctx(p, lds, layer);
}
DI void phase_peer_scores(const Params& p, LAS uchar* lds, int layer, bool xonly) {
    const int tid = threadIdx.x, wave = __builtin_amdgcn_readfirstlane(tid >> 6), lane = tid & 63, r = lane & 31, h = lane >> 5, wf = wave >> 2, wt = wave & 3;
    const bf16_t* PQ = (const bf16_t*)(p.ws + OFF_PQ);
    const bf16_t* keys = (const bf16_t*)(p.ws + OFF_PKEYS) + (size_t)layer * 16 * 128 * 128;
    bf16_t* scores = (bf16_t*)(p.ws + OFF_SCORES);
    const int nF = 16, nT = xonly ? NB * 32 : NT / 256;
    for (int t = blockIdx.x; t < nF * nT; t += gridDim.x) {
        const int ft = t % nF, tt = t / nF;
        const int tok0 = xonly ? (tt / 32) * TPB + LCTX + (tt % 32) * 256 : tt * 256;
        f32x16 sc[2][2];
        gemm_block<2, 2, 2>(lds, keys + (size_t)ft * 128 * 128, 128, PQ + (size_t)tok0 * 2048 + ft * 128, 2048, 128, sc);
#pragma unroll
        for (int j = 0; j < 2; ++j) {
            const int tok = tok0 + wt * 64 + j * 32 + r;
            bf16_t* dst = scores + (size_t)tok * 2048 + ft * 128 + wf * 64;
#pragma unroll
            for (int i = 0; i < 2; ++i)
#pragma unroll
                for (int g4 = 0; g4 < 4; ++g4)
                    *(u32x2*)(dst + i * 32 + 8 * g4 + 4 * h) = (u32x2){pk2(sc[i][j][4 * g4], sc[i][j][4 * g4 + 1]), pk2(sc[i][j][4 * g4 + 2], sc[i][j][4 * g4 + 3])};
        }
    }
}

DI void phase_peer_scores_fused(const Params& p, LAS uchar* lds, int layer, bool xonly) {
    const int tid = threadIdx.x, wave = __builtin_amdgcn_readfirstlane(tid >> 6), lane = tid & 63, r = lane & 31, h = lane >> 5, wf = wave >> 2, wt = wave & 3;
    const bf16_t* Wt = (const bf16_t*)(p.ws + OFF_PWQ) + (size_t)layer * 2048 * 1024;
    const bf16_t* X = (const bf16_t*)(p.ws + OFF_HBF);
    const bf16_t* keys = (const bf16_t*)(p.ws + OFF_PKEYS) + (size_t)layer * 16 * 128 * 128;
    bf16_t* scores = (bf16_t*)(p.ws + OFF_SCORES);
    const int nF = 16, nT = xonly ? NB * 32 : NT / 256;
    for (int t = blockIdx.x; t < nF * nT; t += gridDim.x) {
        const int ft = t % nF, tt = t / nF;
        const int tok0 = xonly ? (tt / 32) * TPB + LCTX + (tt % 32) * 256 : tt * 256;
        f32x16 acc[2][2];
        gemm_block<2, 2, 3>(lds, Wt + (size_t)ft * 128 * 1024, 1024, X + (size_t)tok0 * 1024, 1024, 1024, acc);
        dma_t128(lds + 65536, (const uchar*)(keys + (size_t)ft * 128 * 128), 256, 128, wave, lane);
        dma_t128(lds + 65536 + 16384, (const uchar*)(keys + (size_t)ft * 128 * 128 + 64), 256, 128, wave, lane);
#pragma unroll
        for (int j = 0; j < 2; ++j) {
            const int tl = wt * 64 + j * 32 + r;
#pragma unroll
            for (int i = 0; i < 2; ++i)
#pragma unroll
                for (int g4 = 0; g4 < 4; ++g4) {
                    u32x2 w; w.x = pk2(acc[i][j][4 * g4], acc[i][j][4 * g4 + 1]); w.y = pk2(acc[i][j][4 * g4 + 2], acc[i][j][4 * g4 + 3]);
                    *(LAS u32x2*)(lds + wf * 32768 + t128_off(tl, i * 4 + g4) + 8 * h) = w;
                }
        }
        WAIT_VM0();
        __syncthreads();
        f32x16 sc[2][2];
#pragma unroll
        for (int i = 0; i < 2; ++i)
#pragma unroll
            for (int j = 0; j < 2; ++j)
#pragma unroll
                for (int e = 0; e < 16; ++e) sc[i][j][e] = 0.f;
#pragma unroll
        for (int dh = 0; dh < 2; ++dh)
#pragma unroll
            for (int kk = 0; kk < 4; ++kk) {
                bf16x8 a[2], bq[2];
#pragma unroll
                for (int i = 0; i < 2; ++i) a[i] = ldsfrag(lds + 65536 + dh * 16384, t128_off(wf * 64 + i * 32 + r, 2 * kk + h));
#pragma unroll
                for (int j = 0; j < 2; ++j) bq[j] = ldsfrag(lds + dh * 32768, t128_off(wt * 64 + j * 32 + r, 2 * kk + h));
#pragma unroll
                for (int i = 0; i < 2; ++i)
#pragma unroll
                    for (int j = 0; j < 2; ++j) sc[i][j] = MFMA32(a[i], bq[j], sc[i][j]);
            }
#pragma unroll
        for (int j = 0; j < 2; ++j) {
            const int tok = tok0 + wt * 64 + j * 32 + r;
            bf16_t* dst = scores + (size_t)tok * 2048 + ft * 128 + wf * 64;
#pragma unroll
            for (int i = 0; i < 2; ++i)
#pragma unroll
                for (int g4 = 0; g4 < 4; ++g4)
                    *(u32x2*)(dst + i * 32 + 8 * g4 + 4 * h) = (u32x2){pk2(sc[i][j][4 * g4], sc[i][j][4 * g4 + 1]), pk2(sc[i][j][4 * g4 + 2], sc[i][j][4 * g4 + 3])};
        }
        __syncthreads();
    }
}

DI int fkey(float x) { return __float_as_int(x); }
DI float funkey(int k) { return __int_as_float(k); }
DI int kmax(int a, int b) { int d; asm("v_max_f32 %0, %1, %2" : "=v"(d) : "v"(a), "v"(b)); return d; }
DI int kmin(int a, int b) { int d; asm("v_min_f32 %0, %1, %2" : "=v"(d) : "v"(a), "v"(b)); return d; }
constexpr int KEY_MIN = (int)0xff800000;
DI void ce_desc(int& a, int& b) { const int mx = kmax(a, b), mn = kmin(a, b); a = mx; b = mn; }
DI void sort16_desc(int (&v)[16]) {
#pragma unroll
    for (int k = 2; k <= 16; k <<= 1)
#pragma unroll
        for (int j = k >> 1; j > 0; j >>= 1)
#pragma unroll
            for (int i = 0; i < 16; ++i) {
                const int l = i ^ j;
                if (l > i) { if ((i & k) == 0) ce_desc(v[i], v[l]); else ce_desc(v[l], v[i]); }
            }
}
DI void merge16_desc(int (&top)[16], const int (&v)[16]) {
#pragma unroll
    for (int i = 0; i < 16; ++i) top[i] = kmax(top[i], v[15 - i]);
#pragma unroll
    for (int j = 8; j > 0; j >>= 1)
#pragma unroll
        for (int i = 0; i < 16; ++i) {
            const int l = i ^ j;
            if (l > i) ce_desc(top[i], top[l]);
        }
}
DI void topk_group(const Params& p, LAS uchar* wl, int tok0, int lane, int wmask = 15) {
    const bf16_t* scores = (const bf16_t*)(p.ws + OFF_SCORES);
    int tk[16];
#pragma unroll
    for (int i = 0; i < 16; ++i) tk[i] = KEY_MIN;
    for (int chunk = 0; chunk < 2; ++chunk) {
        u32x4 ld[8];
#pragma unroll
        for (int q = 0; q < 8; ++q) {
            const int rr = q * 8 + (lane >> 3);
            ld[q] = *(const u32x4*)(scores + (size_t)(tok0 + (rr >> 4)) * 2048 + (rr & 15) * 128 + chunk * 64 + (lane & 7) * 8);
        }
#pragma unroll
        for (int q = 0; q < 8; ++q) *(LAS u32x4*)(wl + (q * 8 + (lane >> 3)) * 144 + (lane & 7) * 16) = ld[q];
#pragma unroll
        for (int q2 = 0; q2 < 4; ++q2) {
            int blk[16];
#pragma unroll
            for (int qq = 0; qq < 2; ++qq) {
                const int q = 2 * q2 + qq;
                const u32x4 v = *(const LAS u32x4*)(wl + lane * 144 + q * 16);
                const float vv[8] = {bflo(v.x), bfhi(v.x), bflo(v.y), bfhi(v.y), bflo(v.z), bfhi(v.z), bflo(v.w), bfhi(v.w)};
#pragma unroll
                for (int e = 0; e < 8; ++e) blk[8 * qq + e] = (fkey(vv[e]) & ~127) | (chunk * 64 + q * 8 + e);
            }
            sort16_desc(blk);
            merge16_desc(tk, blk);
        }
    }
    float av[16], bv[16];
#pragma unroll
    for (int i = 0; i < 16; ++i) {
        const int pk = __builtin_amdgcn_update_dpp(0, tk[i], 0xB1, 0xF, 0xF, false);
        av[i] = funkey(tk[i] & ~127); bv[i] = funkey(pk & ~127);
        *(LAS int*)(wl + lane * 144 + i * 4) = tk[i] & 127;
        *(LAS int*)(wl + lane * 144 + 64 + i * 4) = pk & 127;
    }
    int ck[16];
#pragma unroll
    for (int i = 0; i < 16; ++i) ck[i] = KEY_MIN;
    {
        int blk[16];
        blk[0] = (fkey(av[0] + bv[0]) & ~255) | 0;
        blk[1] = (fkey(av[0] + bv[1]) & ~255) | 1;
        blk[2] = (fkey(av[0] + bv[2]) & ~255) | 2;
        blk[3] = (fkey(av[0] + bv[3]) & ~255) | 3;
        blk[4] = (fkey(av[0] + bv[4]) & ~255) | 4;
        blk[5] = (fkey(av[0] + bv[5]) & ~255) | 5;
        blk[6] = (fkey(av[0] + bv[6]) & ~255) | 6;
        blk[7] = (fkey(av[0] + bv[7]) & ~255) | 7;
        blk[8] = (fkey(av[0] + bv[8]) & ~255) | 8;
        blk[9] = (fkey(av[0] + bv[9]) & ~255) | 9;
        blk[10] = (fkey(av[0] + bv[10]) & ~255) | 10;
        blk[11] = (fkey(av[0] + bv[11]) & ~255) | 11;
        blk[12] = (fkey(av[0] + bv[12]) & ~255) | 12;
        blk[13] = (fkey(av[0] + bv[13]) & ~255) | 13;
        blk[14] = (fkey(av[0] + bv[14]) & ~255) | 14;
        blk[15] = (fkey(av[0] + bv[15]) & ~255) | 15;
        sort16_desc(blk);
        merge16_desc(ck, blk);
    }
    {
        int blk[16];
        blk[0] = (fkey(av[1] + bv[0]) & ~255) | 16;
        blk[1] = (fkey(av[1] + bv[1]) & ~255) | 17;
        blk[2] = (fkey(av[1] + bv[2]) & ~255) | 18;
        blk[3] = (fkey(av[1] + bv[3]) & ~255) | 19;
        blk[4] = (fkey(av[1] + bv[4]) & ~255) | 20;
        blk[5] = (fkey(av[1] + bv[5]) & ~255) | 21;
        blk[6] = (fkey(av[1] + bv[6]) & ~255) | 22;
        blk[7] = (fkey(av[1] + bv[7]) & ~255) | 23;
        blk[8] = (fkey(av[2] + bv[0]) & ~255) | 32;
        blk[9] = (fkey(av[2] + bv[1]) & ~255) | 33;
        blk[10] = (fkey(av[2] + bv[2]) & ~255) | 34;
        blk[11] = (fkey(av[2] + bv[3]) & ~255) | 35;
        blk[12] = (fkey(av[2] + bv[4]) & ~255) | 36;
        blk[13] = (fkey(av[3] + bv[0]) & ~255) | 48;
        blk[14] = (fkey(av[3] + bv[1]) & ~255) | 49;
        blk[15] = (fkey(av[3] + bv[2]) & ~255) | 50;
        sort16_desc(blk);
        merge16_desc(ck, blk);
    }
    {
        int blk[16];
        blk[0] = (fkey(av[3] + bv[3]) & ~255) | 51;
        blk[1] = (fkey(av[4] + bv[0]) & ~255) | 64;
        blk[2] = (fkey(av[4] + bv[1]) & ~255) | 65;
        blk[3] = (fkey(av[4] + bv[2]) & ~255) | 66;
        blk[4] = (fkey(av[5] + bv[0]) & ~255) | 80;
        blk[5] = (fkey(av[5] + bv[1]) & ~255) | 81;
        blk[6] = (fkey(av[6] + bv[0]) & ~255) | 96;
        blk[7] = (fkey(av[6] + bv[1]) & ~255) | 97;
        blk[8] = (fkey(av[7] + bv[0]) & ~255) | 112;
        blk[9] = (fkey(av[7] + bv[1]) & ~255) | 113;
        blk[10] = (fkey(av[8] + bv[0]) & ~255) | 128;
        blk[11] = (fkey(av[9] + bv[0]) & ~255) | 144;
        blk[12] = (fkey(av[10] + bv[0]) & ~255) | 160;
        blk[13] = (fkey(av[11] + bv[0]) & ~255) | 176;
        blk[14] = (fkey(av[12] + bv[0]) & ~255) | 192;
        blk[15] = (fkey(av[13] + bv[0]) & ~255) | 208;
        sort16_desc(blk);
        merge16_desc(ck, blk);
    }
    {
        int blk[16];
        blk[0] = (fkey(av[14] + bv[0]) & ~255) | 224;
        blk[1] = (fkey(av[15] + bv[0]) & ~255) | 240;
        blk[2] = KEY_MIN;
        blk[3] = KEY_MIN;
        blk[4] = KEY_MIN;
        blk[5] = KEY_MIN;
        blk[6] = KEY_MIN;
        blk[7] = KEY_MIN;
        blk[8] = KEY_MIN;
        blk[9] = KEY_MIN;
        blk[10] = KEY_MIN;
        blk[11] = KEY_MIN;
        blk[12] = KEY_MIN;
        blk[13] = KEY_MIN;
        blk[14] = KEY_MIN;
        blk[15] = KEY_MIN;
        sort16_desc(blk);
        merge16_desc(ck, blk);
    }
    float cv[16]; int cp[16];
#pragma unroll
    for (int k = 0; k < 16; ++k) {
        const int pos = ck[k] & 255;
        const int n1 = *(const LAS int*)(wl + lane * 144 + (pos >> 4) * 4), n2 = *(const LAS int*)(wl + lane * 144 + 64 + (pos & 15) * 4);
        cp[k] = n1 * 128 + n2;
        cv[k] = funkey(ck[k] & ~255);
    }
    float ge[16]; float gs = 0.f;
#pragma unroll
    for (int k = 0; k < 16; ++k) { ge[k] = __expf(cv[k] - cv[0]); gs += ge[k]; }
    const float ginv = 1.0f / gs;
    if ((lane & 1) == 0 && ((wmask >> (lane >> 4)) & 1)) {
        const int tok = tok0 + (lane >> 4), hd = (lane >> 1) & 7;
        unsigned short* ep = (unsigned short*)(p.ws + OFF_EIDX) + (size_t)tok * 128 + hd * 16;
        float* gp = (float*)(p.ws + OFF_GATE) + (size_t)tok * 128 + hd * 16;
        *(u32x4*)(ep) = (u32x4){(unsigned)cp[0] | ((unsigned)cp[1] << 16), (unsigned)cp[2] | ((unsigned)cp[3] << 16), (unsigned)cp[4] | ((unsigned)cp[5] << 16), (unsigned)cp[6] | ((unsigned)cp[7] << 16)};
        *(u32x4*)(ep + 8) = (u32x4){(unsigned)cp[8] | ((unsigned)cp[9] << 16), (unsigned)cp[10] | ((unsigned)cp[11] << 16), (unsigned)cp[12] | ((unsigned)cp[13] << 16), (unsigned)cp[14] | ((unsigned)cp[15] << 16)};
#pragma unroll
        for (int q = 0; q < 4; ++q) *(f32x4*)(gp + 4 * q) = (f32x4){ge[4 * q] * ginv, ge[4 * q + 1] * ginv, ge[4 * q + 2] * ginv, ge[4 * q + 3] * ginv};
    }
}
DI void phase_peer_topk(const Params& p, LAS uchar* lds, bool xonly) {
    const int tid = threadIdx.x, wave = __builtin_amdgcn_readfirstlane(tid >> 6), lane = tid & 63;
    LAS uchar* wl = lds + wave * 9216;
    const int ngroups = (xonly ? NB * SEQ : NT) / 4;
    const int stride = gridDim.x * NW, nfull = (ngroups / stride) * stride;
    for (int gi = blockIdx.x * NW + wave; gi < nfull; gi += stride) {
        const int rix0 = gi * 4;
        topk_group(p, wl, xonly ? (rix0 / SEQ) * TPB + LCTX + (rix0 % SEQ) : rix0, lane);
    }
    if (wave == 0)
        for (int gi = nfull + blockIdx.x; gi < ngroups; gi += gridDim.x) {
            const int rix0 = gi * 4;
            topk_group(p, wl, xonly ? (rix0 / SEQ) * TPB + LCTX + (rix0 % SEQ) : rix0, lane);
        }
}

DI float gelu_f(float v) {
    const float t = __builtin_amdgcn_rcpf(fabsf(v) * 0.2316418882f + 1.0f);
    float q = t * 0.5307027145f + (-0.7265760135f); q = q * t + 0.7107068705f; q = q * t + (-0.142248368f); q = q * t + 0.127414796f; q = q * t;
    const float m = v * (q * __builtin_amdgcn_exp2f((v * v) * (-0.72134752044f)));
    return v < 0.f ? m : v - m;
}
template <bool FUSE>
DI void phase_peer_gather(const Params& p, LAS uchar* lds, int layer, bool xonly, bool last, bool dry = false, bool ctxtail = false) {
    const int tid = threadIdx.x, wave = __builtin_amdgcn_readfirstlane(tid >> 6), lane = tid & 63;
    LAS uchar* wl = lds + wave * 9216;
    const uchar* PU = p.ws + OFF_PU + (size_t)layer * 16384 * 512;
    const uchar* PV = p.ws + OFF_PV + (size_t)layer * 16384 * 512;
    const float* mod = (const float*)(p.ws + OFF_MOD);
    const int nrows = xonly ? NB * SEQ : NT;
    const int qq = lane >> 4, c16 = lane & 15;
    const int ntask = FUSE ? nrows / 4 : nrows;
    const int stride = gridDim.x * NW, nfull = (ntask / stride) * stride;
    const bool splittail = FUSE ? ctxtail : (ntask - nfull) == 2 * (int)gridDim.x;
    const int nloop = (splittail && !FUSE) ? nfull : ntask;
    int tail_it = 0;
    for (int round = 0; ; ++round) {
      const int task = blockIdx.x * NW + wave + round * stride;
      bool split = false; int h0 = 0, h1 = 8, rixs = 0, toks = 0;
      if (task >= nloop) {
          if (!splittail) break;
          const int pair = blockIdx.x + tail_it * (int)gridDim.x;
          if (FUSE) {
              if (pair >= NB * LCTX / 2) break;
              const int c0 = 2 * pair, g0 = c0 & ~3;
              if (wave == 0) { topk_group(p, wl, (g0 / LCTX) * TPB + (g0 % LCTX), lane, 3 << (c0 & 3)); asm volatile("s_waitcnt vmcnt(0)" ::: "memory"); }
              __syncthreads();
              toks = (c0 / LCTX) * TPB + (c0 % LCTX) + (wave >> 2);
          } else {
              if (tail_it) break;
              rixs = nfull + blockIdx.x * 2 + (wave >> 2);
          }
          ++tail_it;
          split = true; h0 = (wave & 3) * 2; h1 = h0 + 2;
      }
      if (FUSE && !split) {
          const int rix0 = task * 4;
          topk_group(p, wl, xonly ? (rix0 / SEQ) * TPB + LCTX + (rix0 % SEQ) : rix0, lane);
          asm volatile("s_waitcnt vmcnt(0)" ::: "memory");
      }
#pragma unroll 1
      for (int tsub = 0; tsub < ((FUSE && !split) ? 4 : 1); ++tsub) {
        const int rix = split ? rixs : (FUSE ? task * 4 + tsub : task);
        const int tok = (FUSE && split) ? toks : xonly ? (rix / SEQ) * TPB + LCTX + (rix % SEQ) : rix;
        const int mid = mod_id(tok);
        i32x8 hb[8];
        {
            const uchar* h8 = p.ws + OFF_H8 + (size_t)tok * DM + qq * 16;
#pragma unroll
            for (int kb = 0; kb < 8; ++kb) {
                const u32x4 lo = *(const u32x4*)(h8 + kb * 128), hi = *(const u32x4*)(h8 + kb * 128 + 64);
                hb[kb] = (i32x8){(int)lo.x, (int)lo.y, (int)lo.z, (int)lo.w, (int)hi.x, (int)hi.y, (int)hi.z, (int)hi.w};
            }
        }
        const unsigned eip = ((const unsigned*)((const unsigned short*)(p.ws + OFF_EIDX) + (size_t)tok * 128))[lane];
        const f32x2 gtp = ((const f32x2*)((const float*)(p.ws + OFF_GATE) + (size_t)tok * 128))[lane];
        f32x2 out2[8];
#pragma unroll
        for (int e = 0; e < 8; ++e) out2[e] = (f32x2){0.f, 0.f};
        for (int hd = h0; hd < h1; ++hd) {
            u32x4 ua[8];
            {
                const unsigned prl = (unsigned)__shfl((int)eip, hd * 8 + (c16 >> 1));
                const unsigned exl = (c16 & 1) ? (prl >> 16) : (prl & 0xffffu);
                const uchar* urow = PU + (size_t)exl * 512 + qq * 16;
#pragma unroll
                for (int kb = 0; kb < 8; ++kb) ua[kb] = *(const u32x4*)(urow + kb * 64);
            }
            int ex[16]; u32x2 ub[16];
#pragma unroll
            for (int k = 0; k < 16; ++k) {
                const unsigned pr = (unsigned)__builtin_amdgcn_readlane((int)eip, hd * 8 + (k >> 1));
                ex[k] = (k & 1) ? (int)(pr >> 16) : (int)(pr & 0xffffu);
                ub[k] = *(const u32x2*)(PV + (size_t)ex[k] * 512 + 8 * lane);
            }
            f32x4 za = (f32x4){0.f, 0.f, 0.f, 0.f}, zb = za;
#pragma unroll
            for (int kb = 0; kb < 8; kb += 2) {
                za = __builtin_amdgcn_mfma_scale_f32_16x16x128_f8f6f4((i32x8){(int)ua[kb].x, (int)ua[kb].y, (int)ua[kb].z, (int)ua[kb].w, 0, 0, 0, 0}, hb[kb], za, 4, 0, 0, 0x7f7f7f7f, 0, 0x7f7f7f7f);
                zb = __builtin_amdgcn_mfma_scale_f32_16x16x128_f8f6f4((i32x8){(int)ua[kb + 1].x, (int)ua[kb + 1].y, (int)ua[kb + 1].z, (int)ua[kb + 1].w, 0, 0, 0, 0}, hb[kb + 1], zb, 4, 0, 0, 0x7f7f7f7f, 0, 0x7f7f7f7f);
            }
            za += zb;
            const int e4 = lane & 3, kl = 4 * qq + e4;
            const float zl = e4 == 0 ? za[0] : e4 == 1 ? za[1] : e4 == 2 ? za[2] : za[3];
            const float g0 = __shfl(gtp.x, hd * 8 + (kl >> 1)), g1 = __shfl(gtp.y, hd * 8 + (kl >> 1));
            const float zz = zl * (1.0f / 64.0f);
            const float a = gelu_f(zz) * ((kl & 1) ? g1 : g0);
#pragma unroll
            for (int k = 0; k < 16; ++k) {
                const float ak = __int_as_float(__builtin_amdgcn_readlane(__float_as_int(a), 16 * (k >> 2) + (k & 3)));
#pragma unroll
                for (int q = 0; q < 2; ++q) {
                    const f32x2 ak2 = (f32x2){ak, ak};
                    out2[4 * q] += ak2 * __builtin_amdgcn_cvt_scalef32_pk_f32_fp4(ub[k][q], 1.0f, 0);
                    out2[4 * q + 1] += ak2 * __builtin_amdgcn_cvt_scalef32_pk_f32_fp4(ub[k][q], 1.0f, 1);
                    out2[4 * q + 2] += ak2 * __builtin_amdgcn_cvt_scalef32_pk_f32_fp4(ub[k][q], 1.0f, 2);
                    out2[4 * q + 3] += ak2 * __builtin_amdgcn_cvt_scalef32_pk_f32_fp4(ub[k][q], 1.0f, 3);
                }
            }
        }
        if (split) {
#pragma unroll
            for (int q = 0; q < 4; ++q) *(LAS f32x4*)(lds + wave * 4096 + lane * 64 + q * 16) = (f32x4){out2[2 * q][0], out2[2 * q][1], out2[2 * q + 1][0], out2[2 * q + 1][1]};
            __syncthreads();
            if (wave & 3) continue;
#pragma unroll
            for (int w = 1; w < 4; ++w)
#pragma unroll
                for (int q = 0; q < 4; ++q) {
                    const f32x4 t4 = *(const LAS f32x4*)(lds + (wave + w) * 4096 + lane * 64 + q * 16);
                    out2[2 * q][0] += t4[0]; out2[2 * q][1] += t4[1]; out2[2 * q + 1][0] += t4[2]; out2[2 * q + 1][1] += t4[3];
                }
        }
        float* rrow = res_row(p, tok) + 16 * lane;
        bf16_t* rb = resb_row(p, tok) + 16 * lane;
        const float* mm = mod + (size_t)(layer * 3 + mid) * 6144;
        float xn[16]; float ss = 0.f;
#pragma unroll
        for (int q = 0; q < 4; ++q) {
            const f32x4 g = *(const f32x4*)(mm + 5 * 1024 + 16 * lane + 4 * q), x0 = ld4bf(rb + 4 * q);
            f32x4 o;
#pragma unroll
            for (int e = 0; e < 4; ++e) { o[e] = x0[e] + g[e] * (0.5f * out2[2 * q + (e >> 1)][e & 1]); xn[4 * q + e] = o[e]; ss += o[e] * o[e]; }
            if (!dry) { if (last) *(f32x4*)(rrow + 4 * q) = o; else st4bf(rb + 4 * q, o); }
        }
        if (dry) { if (ss == 123.456f) rrow[0] = ss; continue; }
        if (!last) {
            ss = wave_sum(ss);
            const float rstd = rsqrtf(ss * (1.0f / 1024.0f) + EPS);
            const float* mn = mod + (size_t)((layer + 1) * 3 + mid) * 6144 + 16 * lane;
            const float* gn = p.norm1 + (layer + 1) * DM + 16 * lane;
            bf16_t* hdst = (bf16_t*)(p.ws + OFF_HBF) + (size_t)tok * DM + 16 * lane;
            float y[16];
#pragma unroll
            for (int e = 0; e < 16; ++e) y[e] = xn[e] * rstd * gn[e] * (1.0f + mn[1024 + e]) + mn[e];
            *(u32x4*)(hdst) = (u32x4){pk2(y[0], y[1]), pk2(y[2], y[3]), pk2(y[4], y[5]), pk2(y[6], y[7])};
            *(u32x4*)(hdst + 8) = (u32x4){pk2(y[8], y[9]), pk2(y[10], y[11]), pk2(y[12], y[13]), pk2(y[14], y[15])};
        }
      }
    }
}

struct EpiInOdd {
    static constexpr bool PERM = true, AFTER_DRAIN = false;
    const Params* pp;
    DI void operator()(const f32x4 (&acc)[2][2][4][2], const pg8::Unit& u, int wr, int wc, int fr, int fq) const {
        const Params& p = *pp;
        bf16_t* proj1 = (bf16_t*)(p.ws + OFF_PROJ1);
        float* ssq64 = (float*)(p.ws + OFF_SSQ64);
        const int fw = u.pn * 256 + wc * 64;
#pragma unroll
        for (int ai = 0; ai < 2; ++ai)
#pragma unroll
            for (int m = 0; m < 4; ++m) {
                const int tok = u.pm * 256 + ai * 128 + wr * 64 + m * 16 + fr;
                bf16_t* dst = proj1 + (size_t)tok * 2048 + fw + 8 * fq;
                float ss = 0.f;
#pragma unroll
                for (int bj = 0; bj < 2; ++bj) {
                    const f32x4 v0 = acc[ai][bj][m][0], v1 = acc[ai][bj][m][1];
                    ss += v0[0] * v0[0] + v0[1] * v0[1] + v0[2] * v0[2] + v0[3] * v0[3] + v1[0] * v1[0] + v1[1] * v1[1] + v1[2] * v1[2] + v1[3] * v1[3];
                    *(u32x4*)(dst + 32 * bj) = (u32x4){pk2(v0[0], v0[1]), pk2(v0[2], v0[3]), pk2(v1[0], v1[1]), pk2(v1[2], v1[3])};
                }
                if (fw < 384) {
                    ss += __shfl_xor(ss, 16); ss += __shfl_xor(ss, 32);
                    if (fq == 0) ssq64[(size_t)tok * 8 + (fw >> 6)] = ss;
                }
            }
    }
};
DI void phase_inproj_odd_ctx(const Params& p, LAS uchar* lds) {
    const int tid = threadIdx.x, wave = __builtin_amdgcn_readfirstlane(tid >> 6), lane = tid & 63, r = lane & 31, h = lane >> 5, wf = wave >> 2, wt = wave & 3;
    const bf16_t* Wt = (const bf16_t*)(p.ws + OFF_WINO);
    const bf16_t* X = (const bf16_t*)(p.ws + OFF_HBF);
    bf16_t* proj1 = (bf16_t*)(p.ws + OFF_PROJ1);
    float* ssq64 = (float*)(p.ws + OFF_SSQ64);
    const int nF = 32;
    for (int t = blockIdx.x; t < nF * NB * 2; t += gridDim.x) {
        const int ft = t % nF, rest = t / nF, tok0 = (rest >> 1) * TPB + (rest & 1) * 128;
        f32x16 acc[1][1];
        gemm_block<1, 1, 3>(lds, Wt + (size_t)ft * 64 * 1024, 1024, X + (size_t)tok0 * 1024, 1024, 1024, acc);
        const int qa = 2 * ft + wf, q = qa & 7, fw = 256 * (qa >> 3) + 64 * (q & 3), col0 = fw + 32 * (q >> 2);
#pragma unroll
        for (int j = 0; j < 1; ++j) {
            const int tok = tok0 + wt * 32 + r;
            bf16_t* dst = proj1 + (size_t)tok * 2048 + col0;
            float ss = 0.f;
#pragma unroll
            for (int g4 = 0; g4 < 4; ++g4) {
                const float a0 = acc[0][j][4 * g4], a1 = acc[0][j][4 * g4 + 1], a2 = acc[0][j][4 * g4 + 2], a3 = acc[0][j][4 * g4 + 3];
                ss += a0 * a0 + a1 * a1 + a2 * a2 + a3 * a3;
                *(u32x2*)(dst + 8 * g4 + 4 * h) = (u32x2){pk2(a0, a1), pk2(a2, a3)};
            }
            if (fw < 384) {
                ss += __shfl_xor(ss, 32);
                if (h == 0) atomicAdd(&ssq64[(size_t)tok * 8 + (fw >> 6)], ss);
            }
        }
    }
}
DI void phase_inproj_odd(const Params& p, LAS uchar* lds) {
    const pg8::Gemm g{(const bf16_t*)(p.ws + OFF_HBF), (const bf16_t*)(p.ws + OFF_WINO), NT, 2048, 1024};
    const TileOrder S{8, 8 * NB * 32, true};
    const EpiInOdd E{&p};
    pg8::gemm_phase<EpiInOdd, TileOrder, true, true>(lds, g, S, E);
    phase_inproj_odd_ctx(p, lds);
}

constexpr int G_GS = 0, G_GSLD = 65;
struct NoLoads { DI void operator()() const {} };
template <class ML = NoLoads>
DI void gla_gates(const Params& p, LAS uchar* lds, int tok0, int hh, int dir, int gin_off, ML more_loads = ML()) {
    const int tid = threadIdx.x & 255, wave = __builtin_amdgcn_readfirstlane(tid >> 6), lane = tid & 63, r = lane & 31, h = lane >> 5;
    LAS float* Gs = (LAS float*)(lds + G_GS);
    const float* wg = dir ? p.d_wg_b : p.d_wg_f;
    const float* bg = dir ? p.d_bg_b : p.d_bg_f;
    const bf16_t* proj1 = (const bf16_t*)(p.ws + OFF_PROJ1);
    if (tid < 128) {
        const int row = tid >> 1, hf = tid & 1;
        *(LAS u32x4*)(lds + gin_off + row * 32 + hf * 16) = *(const u32x4*)(proj1 + (size_t)(tok0 + row) * 2048 + (dir ? 1968 : 1952) + hf * 8);
    }
    const int cb = (wave >> 1) * 32, kb = (wave & 1) * 32;
    float wv[8];
#pragma unroll
    for (int i = 0; i < 8; ++i) wv[i] = wg[(8 * h + i) * 256 + hh * 64 + kb + r];
    const float bias = bg[hh * 64 + kb + r];
    more_loads();
    unsigned whi[4], wlo[4];
#pragma unroll
    for (int i = 0; i < 4; ++i) {
        whi[i] = pk2(wv[2 * i], wv[2 * i + 1]);
        wlo[i] = pk2(wv[2 * i] - bflo(whi[i]), wv[2 * i + 1] - bfhi(whi[i]));
    }
    LDS_SYNC();
    const bf16x8 a = *(const LAS bf16x8*)(lds + gin_off + (cb + r) * 32 + h * 16);
    f32x16 z;
#pragma unroll
    for (int e = 0; e < 16; ++e) z[e] = 0.f;
    z = MFMA32(a, __builtin_bit_cast(bf16x8, (u32x4){whi[0], whi[1], whi[2], whi[3]}), z);
    z = MFMA32(a, __builtin_bit_cast(bf16x8, (u32x4){wlo[0], wlo[1], wlo[2], wlo[3]}), z);
#pragma unroll
    for (int e = 0; e < 16; ++e) {
        const float zz = z[e] + bias;
        const float ls = fminf(zz, 0.f) - __logf(1.0f + __expf(-fabsf(zz)));
        Gs[(cb + crow(e, h)) * G_GSLD + kb + r] = ls * (1.0f / 16.0f);
    }
}
DI float gla_cumsum(LAS uchar* lds, int dir, int tot_off) {
    const int tid = threadIdx.x & 255, k = tid & 63, blk = tid >> 6;
    LAS float* Gs = (LAS float*)(lds + G_GS);
    LAS float* tot = (LAS float*)(lds + tot_off);
    float v[16];
#pragma unroll
    for (int i = 0; i < 16; ++i) v[i] = Gs[(blk * 16 + i) * G_GSLD + k];
    if (dir == 0) {
#pragma unroll
        for (int i = 1; i < 16; ++i) v[i] += v[i - 1];
    } else {
#pragma unroll
        for (int i = 14; i >= 0; --i) v[i] += v[i + 1];
    }
    tot[blk * 64 + k] = dir == 0 ? v[15] : v[0];
    LDS_SYNC();
    const float t0 = tot[k], t1 = tot[64 + k], t2 = tot[128 + k], t3 = tot[192 + k];
    float off;
    if (dir == 0) off = (blk > 0 ? t0 : 0.f) + (blk > 1 ? t1 : 0.f) + (blk > 2 ? t2 : 0.f);
    else off = (blk < 3 ? t3 : 0.f) + (blk < 2 ? t2 : 0.f) + (blk < 1 ? t1 : 0.f);
#pragma unroll
    for (int i = 0; i < 16; ++i) Gs[(blk * 16 + i) * G_GSLD + k] = v[i] + off;
    return (t0 + t1) + (t2 + t3);
}
DI void gla_build_vt(const Params& p, LAS uchar* vt, int tok0, int hh) {
    const int tid = threadIdx.x & 255, c = tid & 63, vg = tid >> 6;
    const bf16_t* proj1 = (const bf16_t*)(p.ws + OFF_PROJ1);
    const u32x4* sp = (const u32x4*)(proj1 + (size_t)(tok0 + c) * 2048 + 896 + hh * 128 + vg * 32);
#pragma unroll
    for (int q = 0; q < 4; ++q) {
        const u32x4 w = sp[q];
        const unsigned ww[4] = {w.x, w.y, w.z, w.w};
#pragma unroll
        for (int e = 0; e < 4; ++e) {
            const int v = vg * 32 + q * 8 + 2 * e;
            *(LAS bf16_t*)(vt + t128_off(v, c >> 3) + (c & 7) * 2) = (bf16_t)(ww[e] & 0xffffu);
            *(LAS bf16_t*)(vt + t128_off(v + 1, c >> 3) + (c & 7) * 2) = (bf16_t)(ww[e] >> 16);
        }
    }
}

DI void gla_g1_unit(const Params& p, LAS uchar* lds, int u) {
    constexpr int O_KST = 16896, O_VT = 25088, O_BL = 41472;
    const int tid = threadIdx.x & 255, wave = __builtin_amdgcn_readfirstlane(tid >> 6), lane = tid & 63, r = lane & 31, h = lane >> 5;
    const int dir = u / 1056, rem = u % 1056, b = rem / 528, hh = (rem / 132) % 4, n = rem % 132;
    const int tok0 = b * TPB + 64 * n;
    const bf16_t* proj1 = (const bf16_t*)(p.ws + OFF_PROJ1);
    LAS float* Gs = (LAS float*)(lds + G_GS);
    LAS float* bl = (LAS float*)(lds + O_BL);
    gla_gates(p, lds, tok0, hh, dir, 43008);
    LDS_SYNC();
    {
        const float tot = gla_cumsum(lds, dir, O_BL + 256);
        if (tid < 64) { bl[tid] = tot; ((float*)(p.ws + OFF_GDEC))[(size_t)u * 64 + tid] = __expf(tot); }
    }
    LDS_SYNC();
    {
        const int c = tid & 63, kg = tid >> 6;
        const u32x4* kp = (const u32x4*)(proj1 + (size_t)(tok0 + c) * 2048 + 640 + hh * 64 + kg * 16);
#pragma unroll
        for (int q = 0; q < 2; ++q) {
            const u32x4 w = kp[q];
            const unsigned ww[4] = {w.x, w.y, w.z, w.w};
#pragma unroll
            for (int e = 0; e < 4; ++e) {
                const int k = kg * 16 + q * 8 + 2 * e;
                const float v0 = bflo(ww[e]) * __expf(bl[k] - Gs[c * G_GSLD + k]);
                const float v1 = bfhi(ww[e]) * __expf(bl[k + 1] - Gs[c * G_GSLD + k + 1]);
                *(LAS bf16_t*)(lds + O_KST + t128_off(k, c >> 3) + (c & 7) * 2) = f2bf(v0);
                *(LAS bf16_t*)(lds + O_KST + t128_off(k + 1, c >> 3) + (c & 7) * 2) = f2bf(v1);
            }
        }
        gla_build_vt(p, lds + O_VT, tok0, hh);
    }
    LDS_SYNC();
    f32x16 acc[2];
#pragma unroll
    for (int j = 0; j < 2; ++j)
#pragma unroll
        for (int e = 0; e < 16; ++e) acc[j][e] = 0.f;
#pragma unroll
    for (int kk = 0; kk < 4; ++kk) {
        const bf16x8 a = ldsfrag(lds + O_VT, t128_off(wave * 32 + r, 2 * kk + h));
#pragma unroll
        for (int j = 0; j < 2; ++j) acc[j] = MFMA32(a, ldsfrag(lds + O_KST, t128_off(j * 32 + r, 2 * kk + h)), acc[j]);
    }
    bf16_t* ds = (bf16_t*)(p.ws + OFF_GDS) + (size_t)u * 8192;
    const bool odd = r & 1;
#pragma unroll
    for (int j = 0; j < 2; ++j)
#pragma unroll
        for (int i = 0; i < 8; ++i) {
            const float a = acc[j][2 * i], bq = acc[j][2 * i + 1];
            const float recv = __int_as_float(__builtin_amdgcn_update_dpp(0, __float_as_int(odd ? a : bq), 0xB1, 0xF, 0xF, false));
            const int row = wave * 32 + crow(2 * i + (odd ? 1 : 0), h);
            const unsigned w = odd ? pk2(recv, bq) : pk2(a, recv);
            *(unsigned*)(ds + row * 64 + j * 32 + (r & ~1)) = w;
        }
}

DI void gla_scan_task(const Params& p, int bt) {
    const int tid = threadIdx.x;
    const int chain = bt / 16, e = (bt % 16) * NTHR + tid, dir = chain / 8;
    bf16_t* ds = (bf16_t*)(p.ws + OFF_GDS);
    const float* dec = (const float*)(p.ws + OFF_GDEC);
    float S = 0.f;
    for (int base = 0; base < NCHUNK; base += 22) {
        float d[22], t[22]; size_t off[22];
#pragma unroll
        for (int j = 0; j < 22; ++j) {
            const int step = base + j;
            const int n = dir == 0 ? step : (step < 4 ? 3 - step : 135 - step);
            const size_t u = (size_t)chain * NCHUNK + n;
            off[j] = u * 8192 + e;
            d[j] = dec[u * 64 + (e & 63)];
            t[j] = __uint_as_float((unsigned)ds[off[j]] << 16);
        }
#pragma unroll
        for (int j = 0; j < 22; ++j) { ds[off[j]] = f2bf(S); S = d[j] * S + t[j]; }
    }
}

DI void gla_g3_unit(const Params& p, LAS uchar* lds, int v) {
    constexpr int O_AM = 0, O_QT = 16896, O_KIN = 25088, O_VT = 33280, O_ST = 49664, O_SSQ = 66304;
    const int tid = threadIdx.x & 255, wave = __builtin_amdgcn_readfirstlane(tid >> 6), lane = tid & 63, r = lane & 31, h = lane >> 5;
    const int b = v / 512, hh = (v / 128) % 4, n = 4 + (v % 128);
    const int tok0 = b * TPB + 64 * n;
    const bf16_t* proj1 = (const bf16_t*)(p.ws + OFF_PROJ1);
    LAS float* Gs = (LAS float*)(lds + G_GS);
    f32x16 O[2];
#pragma unroll
    for (int j = 0; j < 2; ++j)
#pragma unroll
        for (int e = 0; e < 16; ++e) O[j][e] = 0.f;
    gla_build_vt(p, lds + O_VT, tok0, hh);
    u32x4 wq2[2], wk2[2];
    constexpr unsigned n32 = 16384 * 1024 / 32;
    const float* pu1 = p.p_u + (size_t)16384 * 1024;
    const float* pv1 = p.p_v + (size_t)16384 * 1024;
    for (int dir = 0; dir < 2; ++dir) {
        const int u = ((dir * 2 + b) * 4 + hh) * 132 + n;
        f32x4 cv[8]; u32x4 st4[4];
        const unsigned cslot = (unsigned)(v >> 1) * 2 + (unsigned)dir;
        auto conv_load = [&](unsigned q) {
            const unsigned i = cslot * 1024u + q * 512u + threadIdx.x;
            const bool isu = i < n32; const unsigned j = isu ? i : i - n32;
            const f32x4* src = (const f32x4*)(isu ? pu1 : pv1) + 8 * (size_t)j;
#pragma unroll
            for (int k = 0; k < 8; ++k) cv[k] = src[k];
        };
        auto conv_store = [&](unsigned q) {
            const unsigned i = cslot * 1024u + q * 512u + threadIdx.x;
            const bool isu = i < n32; const unsigned j = isu ? i : i - n32;
            const float sc = isu ? 64.0f : 2.0f;
            u32x4 w;
#pragma unroll
            for (int qq = 0; qq < 4; ++qq) {
                const f32x4 a = cv[2 * qq], bq = cv[2 * qq + 1];
                unsigned d = 0;
                d = __builtin_amdgcn_cvt_scalef32_pk_fp4_f32(d, fminf(fmaxf(a[0] * sc, -6.f), 6.f), fminf(fmaxf(a[1] * sc, -6.f), 6.f), 1.0f, 0);
                d = __builtin_amdgcn_cvt_scalef32_pk_fp4_f32(d, fminf(fmaxf(a[2] * sc, -6.f), 6.f), fminf(fmaxf(a[3] * sc, -6.f), 6.f), 1.0f, 1);
                d = __builtin_amdgcn_cvt_scalef32_pk_fp4_f32(d, fminf(fmaxf(bq[0] * sc, -6.f), 6.f), fminf(fmaxf(bq[1] * sc, -6.f), 6.f), 1.0f, 2);
                d = __builtin_amdgcn_cvt_scalef32_pk_fp4_f32(d, fminf(fmaxf(bq[2] * sc, -6.f), 6.f), fminf(fmaxf(bq[3] * sc, -6.f), 6.f), 1.0f, 3);
                w[qq] = d;
            }
            ((u32x4*)(p.ws + (isu ? OFF_PU : OFF_PV) + (size_t)16384 * 512))[j] = w;
        };
        gla_gates(p, lds, tok0, hh, dir, 67328, [&]() {
            if (dir == 0) {
                const int c = tid & 63, kg = tid >> 6;
                const u32x4* qp = (const u32x4*)(proj1 + (size_t)(tok0 + c) * 2048 + 384 + hh * 64 + kg * 16);
                const u32x4* kp = (const u32x4*)(proj1 + (size_t)(tok0 + c) * 2048 + 640 + hh * 64 + kg * 16);
                wq2[0] = qp[0]; wq2[1] = qp[1]; wk2[0] = kp[0]; wk2[1] = kp[1];
            }
            {
                const u32x4* sp = (const u32x4*)((const bf16_t*)(p.ws + OFF_GDS) + (size_t)u * 8192 + (tid >> 1) * 64 + (tid & 1) * 32);
#pragma unroll
                for (int q = 0; q < 4; ++q) st4[q] = sp[q];
            }
            conv_load(0);
        });
        LDS_SYNC();
        (void)gla_cumsum(lds, dir, O_SSQ);
        LDS_SYNC();
        {
            const int c = tid & 63, kg = tid >> 6;
#pragma unroll
            for (int q = 0; q < 2; ++q) {
                const u32x4 wq = wq2[q], wk = wk2[q];
                const unsigned qq[4] = {wq.x, wq.y, wq.z, wq.w}, kk4[4] = {wk.x, wk.y, wk.z, wk.w};
                unsigned oq[4], ok[4];
#pragma unroll
                for (int e = 0; e < 4; ++e) {
                    const int k = kg * 16 + q * 8 + 2 * e;
                    const float b0 = Gs[c * G_GSLD + k], b1 = Gs[c * G_GSLD + k + 1];
                    oq[e] = pk2(bflo(qq[e]) * 0.125f * __expf(b0), bfhi(qq[e]) * 0.125f * __expf(b1));
                    ok[e] = pk2(bflo(kk4[e]) * __expf(-b0), bfhi(kk4[e]) * __expf(-b1));
                }
                *(LAS u32x4*)(lds + O_QT + t128_off(c, kg * 2 + q)) = (u32x4){oq[0], oq[1], oq[2], oq[3]};
                *(LAS u32x4*)(lds + O_KIN + t128_off(c, kg * 2 + q)) = (u32x4){ok[0], ok[1], ok[2], ok[3]};
            }
            const int sv = tid >> 1, kh = tid & 1;
#pragma unroll
            for (int q = 0; q < 4; ++q) *(LAS u32x4*)(lds + O_ST + t128_off(sv, kh * 4 + q)) = st4[q];
            conv_store(0); conv_load(1);
        }
        LDS_SYNC();
        {
            const int st = wave >> 1, ct = wave & 1;
            f32x16 A;
#pragma unroll
            for (int e = 0; e < 16; ++e) A[e] = 0.f;
#pragma unroll
            for (int kk = 0; kk < 4; ++kk) A = MFMA32(ldsfrag(lds + O_KIN, t128_off(st * 32 + r, 2 * kk + h)), ldsfrag(lds + O_QT, t128_off(ct * 32 + r, 2 * kk + h)), A);
            const int c = ct * 32 + r;
#pragma unroll
            for (int g4 = 0; g4 < 4; ++g4) {
                float a4[4];
#pragma unroll
                for (int e = 0; e < 4; ++e) {
                    const int s = st * 32 + 8 * g4 + 4 * h + e;
                    const bool keep = dir == 0 ? (s <= c) : (s >= c);
                    a4[e] = keep ? A[4 * g4 + e] : 0.f;
                }
                *(LAS u32x2*)(lds + O_AM + t128_off(c, st * 4 + g4) + 8 * h) = (u32x2){pk2(a4[0], a4[1]), pk2(a4[2], a4[3])};
            }
        }
        LDS_SYNC();
#pragma unroll
        for (int kk = 0; kk < 4; ++kk) {
            const bf16x8 av = ldsfrag(lds + O_VT, t128_off(wave * 32 + r, 2 * kk + h));
            const bf16x8 as = ldsfrag(lds + O_ST, t128_off(wave * 32 + r, 2 * kk + h));
#pragma unroll
            for (int j = 0; j < 2; ++j) {
                O[j] = MFMA32(av, ldsfrag(lds + O_AM, t128_off(j * 32 + r, 2 * kk + h)), O[j]);
                O[j] = MFMA32(as, ldsfrag(lds + O_QT, t128_off(j * 32 + r, 2 * kk + h)), O[j]);
            }
        }
        conv_store(1);
        LDS_SYNC();
    }
    LAS float* ssqp = (LAS float*)(lds + O_SSQ);
#pragma unroll
    for (int j = 0; j < 2; ++j) {
        float ss = 0.f;
#pragma unroll
        for (int e = 0; e < 16; ++e) ss += O[j][e] * O[j][e];
        ss += __shfl_xor(ss, 32);
        if (h == 0) ssqp[wave * 64 + j * 32 + r] = ss;
    }
    LDS_SYNC();
    bf16_t* aout = (bf16_t*)(p.ws + OFF_AOUT);
#pragma unroll
    for (int j = 0; j < 2; ++j) {
        const int c = j * 32 + r, tok = tok0 + c;
        const float tot = ssqp[c] + ssqp[64 + c] + ssqp[128 + c] + ssqp[192 + c];
        const float rstd = rsqrtf(tot * (1.0f / 128.0f) + EPS);
#pragma unroll
        for (int g4 = 0; g4 < 4; ++g4) {
            const int v0 = wave * 32 + 8 * g4 + 4 * h;
            const f32x4 gn = *(const f32x4*)(p.d_gn + v0);
            const u32x2 rw = *(const u32x2*)(proj1 + (size_t)tok * 2048 + 1408 + hh * 128 + v0);
            const float y0 = O[j][4 * g4] * rstd * gn[0] * silu_f(bflo(rw.x)), y1 = O[j][4 * g4 + 1] * rstd * gn[1] * silu_f(bfhi(rw.x));
            const float y2 = O[j][4 * g4 + 2] * rstd * gn[2] * silu_f(bflo(rw.y)), y3 = O[j][4 * g4 + 3] * rstd * gn[3] * silu_f(bfhi(rw.y));
            *(u32x2*)(aout + (size_t)tok * DM + 512 + hh * 128 + v0) = (u32x2){pk2(y0, y1), pk2(y2, y3)};
        }
    }
    LDS_SYNC();
}

DI void phase_l1_up(const Params& p, LAS uchar* lds, int parts = 7) {
    const int tid = threadIdx.x, wave = __builtin_amdgcn_readfirstlane(tid >> 6), lane = tid & 63, r = lane & 31, h = lane >> 5, wf = wave >> 2, wt = wave & 3;
    const bf16_t* proj1 = (const bf16_t*)(p.ws + OFF_PROJ1);
    const float* ssq64 = (const float*)(p.ws + OFF_SSQ64);
    const f32x4* ropec = (const f32x4*)(p.ws + OFF_ROPEC);
    const int nGp = 1056;
    const XTiles xq(4, NB * SEQ / 128), xkv(8, NT / 256);
    const int nQl = (xq.count - xq.lb + xq.nlb - 1) / xq.nlb, nKVl = (xkv.count - xkv.lb + xkv.nlb - 1) / xkv.nlb;
    const int bxg = ((int)blockIdx.x + (int)gridDim.x / 2) % (int)gridDim.x;
    const int nGl = (nGp - bxg + (int)gridDim.x - 1) / (int)gridDim.x;
    if (parts & 1) for (int it = 0; it < nQl; ++it) {
        {
            int ft, tt; xq.get(xq.lb + it * xq.nlb, ft, tt);
            tt += 2 + (tt >= SEQ / 128 ? 2 : 0);
            f32x16 acc[3][1];
            gemm_block<3, 1, 3>(lds, (const bf16_t*)(p.ws + OFF_WQUP) + (size_t)ft * 192 * 256, 256, proj1 + (size_t)tt * 128 * 2048, 2048, 256, acc);
            const int hd = ft * 2 + wf;
            const int tok = tt * 128 + wt * 32 + r;
            const int b = tok / TPB, ti = tok - b * TPB; const bool isx = ti >= LCTX; const int pos = ti - LCTX;
            const f32x4 sq = *(const f32x4*)(ssq64 + (size_t)tok * 8);
            const float rcq = rsqrtf((sq[0] + sq[1] + sq[2] + sq[3]) * (1.0f / 256.0f) + EPS);
            float ss = 0.f;
#pragma unroll
            for (int i = 0; i < 3; ++i)
#pragma unroll
                for (int e = 0; e < 16; ++e) { acc[i][0][e] *= rcq; ss += acc[i][0][e] * acc[i][0][e]; }
            ss += __shfl_xor(ss, 32);
            const float rstd = rsqrtf(ss * (1.0f / 96.0f) + EPS);
            const float qs = 0.10206207261596575f * LOG2E;
            bf16_t* dn = (bf16_t*)(p.ws + OFF_CQN) + ((size_t)(b * 8 + hd) * TPB + ti) * 64;
            bf16_t* dr = (bf16_t*)(p.ws + OFF_CQR) + ((size_t)(b * 8 + hd) * TPB + ti) * 32;
#pragma unroll
            for (int i = 0; i < 3; ++i)
#pragma unroll
                for (int g4 = 0; g4 < 4; ++g4) {
                    const int d = i * 32 + 8 * g4 + 4 * h;
                    const f32x4 gg = *(const f32x4*)(p.c_qn + d);
                    float y0 = acc[i][0][4 * g4] * rstd * gg[0], y1 = acc[i][0][4 * g4 + 1] * rstd * gg[1];
                    float y2 = acc[i][0][4 * g4 + 2] * rstd * gg[2], y3 = acc[i][0][4 * g4 + 3] * rstd * gg[3];
                    if (i == 2 && isx) {
                        const f32x4 cs = ropec[((size_t)pos * 16 + ((d - 64) >> 1)) >> 1];
                        const float z0 = y0 * cs[0] - y1 * cs[1], z1 = y0 * cs[1] + y1 * cs[0];
                        const float z2 = y2 * cs[2] - y3 * cs[3], z3 = y2 * cs[3] + y3 * cs[2];
                        y0 = z0; y1 = z1; y2 = z2; y3 = z3;
                    }
                    const u32x2 w = (u32x2){pk2(y0 * qs, y1 * qs), pk2(y2 * qs, y3 * qs)};
                    if (i < 2) *(u32x2*)(dn + d) = w; else *(u32x2*)(dr + (d - 64)) = w;
                }
        }
    }
    if (parts & 2) for (int it = 0; it < nKVl; ++it) {
        {
            int hd, tt; xkv.get(xkv.lb + it * xkv.nlb, hd, tt);
            f32x16 acc[2][2];
            gemm_block<2, 2, 2>(lds, (const bf16_t*)(p.ws + OFF_WKVUP) + (size_t)hd * 128 * 128, 128, proj1 + (size_t)tt * 256 * 2048 + 256, 2048, 128, acc);
            const int tokb = tt * 256 + wt * 64 + r;
            const int b = tokb / TPB, tib = tokb - b * TPB;
            f32x2 sq2[2];
#pragma unroll
            for (int j = 0; j < 2; ++j) sq2[j] = *(const f32x2*)(ssq64 + (size_t)(tokb + j * 32) * 8 + 4);
            if (wf == 0) {
                u32x4 kpa[2], kpb[2]; f32x4 csk[2][4]; f32x4 gk[2][4], gkr[4];
#pragma unroll
                for (int j = 0; j < 2; ++j) {
                    const u32x4* kp = (const u32x4*)(proj1 + (size_t)(tokb + j * 32) * 2048 + 1920 + 16 * h);
                    kpa[j] = kp[0]; kpb[j] = kp[1];
                    const int pos = tib + j * 32 - LCTX, posc = pos < 0 ? 0 : pos;
#pragma unroll
                    for (int m = 0; m < 4; ++m) csk[j][m] = ((const f32x4*)(p.ws + OFF_ROPEC))[((size_t)posc * 16 + 8 * h) / 2 + m];
                }
#pragma unroll
                for (int i = 0; i < 2; ++i)
#pragma unroll
                    for (int g4 = 0; g4 < 4; ++g4) gk[i][g4] = *(const f32x4*)(p.c_kn + i * 32 + 8 * g4 + 4 * h);
#pragma unroll
                for (int q = 0; q < 4; ++q) gkr[q] = *(const f32x4*)(p.c_kn + 64 + 16 * h + 4 * q);
#pragma unroll
                for (int j = 0; j < 2; ++j) {
                    const int ti = tib + j * 32; const bool isx = ti >= LCTX;
                    const float rckv = rsqrtf((sq2[j][0] + sq2[j][1]) * (1.0f / 128.0f) + EPS);
                    float ssn = 0.f;
#pragma unroll
                    for (int i = 0; i < 2; ++i)
#pragma unroll
                        for (int e = 0; e < 16; ++e) { acc[i][j][e] *= rckv; ssn += acc[i][j][e] * acc[i][j][e]; }
                    const u32x4 k0 = kpa[j], k1 = kpb[j];
                    float kpe[16] = {bflo(k0.x), bfhi(k0.x), bflo(k0.y), bfhi(k0.y), bflo(k0.z), bfhi(k0.z), bflo(k0.w), bfhi(k0.w),
                                     bflo(k1.x), bfhi(k1.x), bflo(k1.y), bfhi(k1.y), bflo(k1.z), bfhi(k1.z), bflo(k1.w), bfhi(k1.w)};
#pragma unroll
                    for (int e = 0; e < 16; ++e) ssn += kpe[e] * kpe[e];
                    ssn += __shfl_xor(ssn, 32);
                    const float rstd = rsqrtf(ssn * (1.0f / 96.0f) + EPS);
                    uchar* dn = p.ws + OFF_CKN + ((size_t)(b * 8 + hd) * TPB + ti) * 64;
                    bf16_t* dr = (bf16_t*)(p.ws + OFF_CKR) + ((size_t)(b * 8 + hd) * TPB + ti) * 32 + 16 * h;
#pragma unroll
                    for (int i = 0; i < 2; ++i)
#pragma unroll
                        for (int g4 = 0; g4 < 4; ++g4) {
                            const int d = i * 32 + 8 * g4 + 4 * h;
                            const f32x4 gg = gk[i][g4];
                            int x8 = __builtin_amdgcn_cvt_pk_fp8_f32(acc[i][j][4 * g4] * rstd * gg[0], acc[i][j][4 * g4 + 1] * rstd * gg[1], 0, false);
                            x8 = __builtin_amdgcn_cvt_pk_fp8_f32(acc[i][j][4 * g4 + 2] * rstd * gg[2], acc[i][j][4 * g4 + 3] * rstd * gg[3], x8, true);
                            *(int*)(dn + d) = x8;
                        }
                    unsigned ow[8];
#pragma unroll
                    for (int m = 0; m < 8; ++m) {
                        float y0 = kpe[2 * m] * gkr[m >> 1][(2 * m) & 3] * rstd, y1 = kpe[2 * m + 1] * gkr[m >> 1][(2 * m + 1) & 3] * rstd;
                        if (isx) {
                            const f32x4 c4 = csk[j][m >> 1];
                            const float c = (m & 1) ? c4[2] : c4[0], sn = (m & 1) ? c4[3] : c4[1];
                            const float z0 = y0 * c - y1 * sn, z1 = y0 * sn + y1 * c;
                            y0 = z0; y1 = z1;
                        }
                        ow[m] = pk2(y0, y1);
                    }
                    *(u32x4*)(dr) = (u32x4){ow[0], ow[1], ow[2], ow[3]};
                    *(u32x4*)(dr + 8) = (u32x4){ow[4], ow[5], ow[6], ow[7]};
                }
            } else {
#pragma unroll
                for (int j = 0; j < 2; ++j) {
                    const float rckv = rsqrtf((sq2[j][0] + sq2[j][1]) * (1.0f / 128.0f) + EPS);
                    const int key = j * 32 + r;
                    const int pos = wt * 64 + 32 * ((key >> 2) & 1) + 16 * (key >> 5) + 4 * ((key >> 3) & 3) + (key & 3);
                    LAS uchar* bp = lds + (h * 1024 + pos);
#pragma unroll
                    for (int i = 0; i < 2; ++i)
#pragma unroll
                        for (int e = 0; e < 16; ++e) {
                            const float v = acc[i][j][e] * rckv;
                            bp[(i * 32 + (e & 3) + 8 * (e >> 2)) * 256] = (uchar)__builtin_amdgcn_cvt_pk_fp8_f32(v, v, 0, false);
                        }
                }
            }
            __syncthreads();
            {
                const int tok0 = tt * 256, b0 = tok0 / TPB, ti0 = tok0 - b0 * TPB;
                uchar* dst = p.ws + OFF_CVT + (size_t)(b0 * 8 + hd) * 64 * TPB + ti0;
                for (int idx = tid; idx < 64 * 16; idx += NTHR) {
                    const int row = idx >> 4, pc = idx & 15;
                    *(u32x4*)(dst + (size_t)row * TPB + pc * 16) = *(const LAS u32x4*)(lds + row * 256 + pc * 16);
                }
            }
            __syncthreads();
        }
    }
    if (parts & 4) for (int it = 0; it < nGl; ++it) {
        gla_g1_unit(p, lds + (tid >> 8) * 69632, 2 * (bxg + it * (int)gridDim.x) + (tid >> 8));
        LDS_SYNC();
    }
}

DI void phase_attn_l1(const Params& p, LAS uchar* lds, bool do_scan = true) {
    const int tid = threadIdx.x, wave = __builtin_amdgcn_readfirstlane(tid >> 6), lane = tid & 63, r = lane & 31, h = lane >> 5;
    bf16_t* aout = (bf16_t*)(p.ws + OFF_AOUT);
    const int xcd = blockIdx.x & 7, lb = blockIdx.x >> 3, nlb = gridDim.x >> 3;
    const int nCl = (32 - lb + nlb - 1) / nlb;
    const int nS = do_scan ? (256 - (int)blockIdx.x + (int)gridDim.x - 1) / (int)gridDim.x : 0;
    for (int it = 0; it < nCl + nS; ++it) {
        if (it < nCl) {
            const int u = lb + it * nlb;
            const int combo = xcd + 8 * (u >> 4);
            const int b = combo >> 3, hd = combo & 7, q0 = LCTX + (u & 15) * 512;
            const size_t pl = (size_t)(b * 8 + hd);
            const bf16_t* qw = (const bf16_t*)(p.ws + OFF_CQN) + (pl * TPB + q0 + wave * 64) * 64;
            const bf16_t* qrw = (const bf16_t*)(p.ws + OFF_CQR) + (pl * TPB + q0 + wave * 64) * 32;
            const uchar* kb = p.ws + OFF_CKN + pl * TPB * 64;
            const bf16_t* krb = (const bf16_t*)(p.ws + OFF_CKR) + pl * TPB * 32;
            const uchar* vt8 = p.ws + OFF_CVT + pl * 64 * TPB;
            f32x16 O[2][2]; float l[2];
            attn_core_q2f8<true>(lds, qw, qrw, kb, krb, vt8, NCHUNK, O, l);
#pragma unroll
            for (int g = 0; g < 2; ++g) {
                const float inv = 1.0f / l[g];
                const int tok = b * TPB + q0 + wave * 64 + g * 32 + r;
                bf16_t* dst = aout + (size_t)tok * DM + hd * 64;
#pragma unroll
                for (int d = 0; d < 2; ++d)
#pragma unroll
                    for (int g4 = 0; g4 < 4; ++g4) {
                        const int dv = d * 32 + 8 * g4 + 4 * h;
                        *(u32x2*)(dst + dv) = (u32x2){pk2(O[g][d][4 * g4] * inv, O[g][d][4 * g4 + 1] * inv), pk2(O[g][d][4 * g4 + 2] * inv, O[g][d][4 * g4 + 3] * inv)};
                    }
            }
        } else {
            gla_scan_task(p, (int)blockIdx.x + (it - nCl) * (int)gridDim.x);
        }
    }
}
DI void phase_gla_out(const Params& p, LAS uchar* lds) {
    for (int v = blockIdx.x; v < NB * 4 * 64; v += gridDim.x) gla_g3_unit(p, lds + (threadIdx.x >> 8) * 69632, 2 * v + (int)(threadIdx.x >> 8));
}

#define XB_TMO      128
#define XB_XCNT(j)  (256  + 64 * (j))
#define XB_XSUB(j)  (1280 + 64 * (j))
#define XB_XGEN(j)  (2304 + 64 * (j))
#define XB_TOP      3328
#define XB_TOPGEN   3392
#define XB_SPIN_CAP (1u << 22)
DI unsigned xb_ld(unsigned* p) { return __hip_atomic_load(p, __ATOMIC_RELAXED, __HIP_MEMORY_SCOPE_AGENT); }
DI unsigned xb_add(unsigned* p, unsigned v) { return __hip_atomic_fetch_add(p, v, __ATOMIC_RELAXED, __HIP_MEMORY_SCOPE_AGENT); }
DI unsigned xb_xcc_id() { return (unsigned)__builtin_amdgcn_s_getreg((3 << 11) | 20) & 0xFu; }
#define XB_SPIN(cond, bar) do { unsigned _sp = 0; while (cond) { __builtin_amdgcn_s_sleep(1); \
    if ((++_sp & 255u) == 0u) { if (xb_ld(&(bar)[XB_TMO])) break; if (_sp > XB_SPIN_CAP) { atomicAdd(&(bar)[XB_TMO], 1u); break; } } } } while (0)
struct XcdBarrier { unsigned* bar; unsigned x; volatile LAS unsigned* st; };
DI XcdBarrier xcd_barrier_post(unsigned* bar, volatile LAS unsigned* st) {
    XcdBarrier b; b.bar = bar; b.x = xb_xcc_id(); b.st = st;
    if (threadIdx.x == 0) (void)xb_add(&bar[XB_XCNT(b.x)], 1u);
    return b;
}
DI void xcd_barrier_complete(unsigned* bar, unsigned x, unsigned& nloc, unsigned& nx) {
    const unsigned G = gridDim.x * gridDim.y * gridDim.z;
    unsigned sum, cnt, mine, sp = 0u;
    for (;;) {
        sum = 0u; cnt = 0u; mine = 0u;
#pragma unroll
        for (unsigned j = 0; j < 16; ++j) { const unsigned c = xb_ld(&bar[XB_XCNT(j)]); sum += c; cnt += (c > 0u) ? 1u : 0u; mine = (j == x) ? c : mine; }
        if (sum == G) break;
        __builtin_amdgcn_s_sleep(1);
        if ((++sp & 255u) == 0u) { if (xb_ld(&bar[XB_TMO])) break; if (sp > XB_SPIN_CAP) { atomicAdd(&bar[XB_TMO], 1u); break; } }
    }
    nloc = mine > 0u ? mine : 1u; nx = cnt > 0u ? cnt : 1u;
}
DI void xcd_barrier(const XcdBarrier& b) {
    asm volatile("s_waitcnt vmcnt(0)" ::: "memory");
    __syncthreads();
    if (threadIdx.x == 0) {
        unsigned* bar = b.bar;
        __builtin_amdgcn_s_waitcnt(0);
        unsigned nloc = b.st[0], nx = b.st[1];
        if (nloc == 0u) { xcd_barrier_complete(bar, b.x, nloc, nx); b.st[0] = nloc; b.st[1] = nx; }
        const unsigned old = xb_add(&bar[XB_XSUB(b.x)], 1u);
        const unsigned gen = old / nloc;
        if (old + 1u == (gen + 1u) * nloc) {
            __builtin_amdgcn_fence(__ATOMIC_RELEASE, "agent");
            asm volatile("s_waitcnt vmcnt(0)" ::: "memory");
            (void)xb_add(&bar[XB_TOP], 1u);
            XB_SPIN(xb_ld(&bar[XB_TOP]) < (gen + 1u) * nx, bar);
            __builtin_amdgcn_fence(__ATOMIC_ACQUIRE, "agent");
            xb_add(&bar[XB_XGEN(b.x)], 1u);
            asm volatile("s_waitcnt vmcnt(0)" ::: "memory");
        } else {
            __builtin_amdgcn_fence(__ATOMIC_ACQUIRE, "agent");
            XB_SPIN(xb_ld(&bar[XB_XGEN(b.x)]) == gen, bar);
            asm volatile("s_waitcnt vmcnt(0)" ::: "memory");
        }
    }
    __syncthreads();
}

__global__ void __launch_bounds__(512, 2) fwd_megakernel(Params p) {
    __shared__ __attribute__((aligned(16))) uchar lds_raw[LDS_BYTES];
    LAS uchar* lds = (LAS uchar*)lds_raw;
    cg::grid_group grid = cg::this_grid();
    volatile LAS unsigned* xst = (volatile LAS unsigned*)(lds + LDS_BYTES - 16);
    if (threadIdx.x == 0) { xst[0] = 0u; xst[1] = 0u; }
    __syncthreads();
    const XcdBarrier xb = xcd_barrier_post((unsigned*)(p.ws + OFF_BAR), xst);
#define GRID_SYNC(N) do { if (p.phase_lo < 0) grid.sync(); xcd_barrier(xb); } while (0)
#define RUN_PHASE(N, CALL) if (p.phase_lo <= (N) && (N) < p.phase_hi) { if ((N) > p.phase_lo) GRID_SYNC(N); CALL; }
#ifdef DUP_PHASE
#define DUP(N, CALL) if ((DUP_PHASE >> (N)) & 1) { xcd_barrier(xb); CALL; }
#else
#define DUP(N, CALL)
#endif
#ifdef ONLY_PHASE
#define PH(N, CALL) if ((N) == ONLY_PHASE) { RUN_PHASE(N, CALL) }
#else
#define PH(N, CALL) RUN_PHASE(N, CALL) DUP(N, CALL)
#endif
    PH(0, phase_prep(p, lds))
    PH(1, phase_norm1_l0(p, lds))
    PH(2, phase_inproj_even(p, lds))
    PH(3, { phase_attn_l0(p, lds); conv_tables_dyn(p, lds, 0); })
    PH(4, phase_outproj(p, lds, 0, OFF_WOUTE, false))
    PH(5, phase_norm2(p, 0, false))
    PH(6, phase_peer_pq(p, lds, 0, false))
    PH(7, phase_peer_gather<true>(p, lds, 0, true, false, false, true))
    PH(8, phase_inproj_odd(p, lds))
    PH(9, phase_l1_up(p, lds))
    PH(10, phase_attn_l1(p, lds))
    PH(11, phase_gla_out(p, lds))
    PH(12, phase_outproj(p, lds, 1, OFF_WOUTO, true))
    PH(13, phase_norm2(p, 1, true))
    PH(14, phase_peer_pq(p, lds, 1, true))
    PH(15, phase_peer_gather<true>(p, lds, 1, true, true))
}

extern "C" void kernel_launch(void* const* d_in, const int* in_sizes, int n_in, void* d_out, int out_size, void* d_ws, size_t ws_size,
                              hipStream_t stream) {
    static int grid_blocks = 0;
    if (!grid_blocks) {
        int dev = 0, cus = 0, per_cu = 0;
        (void)hipGetDevice(&dev);
        (void)hipDeviceGetAttribute(&cus, hipDeviceAttributeMultiprocessorCount, dev);
        (void)hipOccupancyMaxActiveBlocksPerMultiprocessor(&per_cu, fwd_megakernel, NTHR, 0);
        if (per_cu > 1) per_cu = 1;
        if (per_cu < 1) per_cu = 1;
        grid_blocks = cus * per_cu;
    }
    Params p{};
    const float** fp = (const float**)&p;
    for (int i = 0; i < 37; ++i) fp[i] = (const float*)d_in[i];
    p.out = (float*)d_out;
    p.ws = (uchar*)d_ws;
    if (ws_size < WS_NEEDED) { fprintf(stderr, "workspace too small: %zu < %zu\n", ws_size, (size_t)WS_NEEDED); }
#if MULTI_LAUNCH
    for (int ph = 0; ph < N_PHASES_RUN; ++ph) {
        p.phase_lo = ph; p.phase_hi = ph + 1;
        hipLaunchKernelGGL(fwd_megakernel, dim3(grid_blocks), dim3(NTHR), 0, stream, p);
    }
#else
    p.phase_lo = 0; p.phase_hi = N_PHASES_RUN;
    (void)hipMemsetAsync((uchar*)d_ws + OFF_BAR, 0, 16384, stream);
    void* args[] = {&p};
    hipError_t e = hipLaunchCooperativeKernel((void*)fwd_megakernel, dim3(grid_blocks), dim3(NTHR), args, 0, stream);
    if (e != hipSuccess) fprintf(stderr, "cooperative launch failed: %s (grid %d)\n", hipGetErrorString(e), grid_blocks);
#endif
}
```
